# Optimizing an MI355X kernel written in HIP

```python
import jax
import jax.numpy as jnp
from jax import lax
import numpy as np

D_MODEL = 1024
BATCH = 1
SEQ = 16384
DEPTH = 2

GRID_W = 64
CTX_LEN = 256
N_MOD = 9
D_FF = 2816
NA_HEADS = 8
NA_HEAD_DIM = 64
NA_WIDTH = NA_HEADS * NA_HEAD_DIM
NA_KH = 8
NA_KW = 16
POOL_WINDOWS = (2, 4, 8, 16)
POOL_GROUPS = len(POOL_WINDOWS)
POOL_WIDTH = D_MODEL - NA_WIDTH
POOL_GROUP_DIM = POOL_WIDTH // POOL_GROUPS
EVEN_IN_WIDTH = 3 * NA_WIDTH + POOL_WIDTH
EVEN_MIX_WIDTH = NA_WIDTH + POOL_WIDTH
CONV_WIDTH = D_MODEL
CONV_K = 3
N_EVEN = (DEPTH + 1) // 2
N_ODD = DEPTH // 2
RMS_EPS = 1e-6
NEG_INF = -1e30

kernel_name = "hybrid_natten_pool_shortconv_dit"


def rms_norm(x, g):
    x32 = x.astype(jnp.float32)
    y = x32 * lax.rsqrt(jnp.mean(x32 * x32, axis=-1, keepdims=True) + RMS_EPS)
    return (y * g.astype(jnp.float32)).astype(x.dtype)


def modulate(h, shift, scale):
    return h * (1 + scale) + shift


def adaln(cond, w, b):
    m = jax.nn.silu(cond) @ w + b
    return m.reshape(m.shape[:-1] + (N_MOD, D_MODEL))


def swiglu(h, w13, w2):
    a, b = jnp.split(h @ w13, 2, axis=-1)
    return (jax.nn.silu(a) * b) @ w2


def ffn_sublayer(h, m, g, w13, w2, base):
    hn = modulate(rms_norm(h, g), m[:, :, base], m[:, :, base + 1])
    return h + 0.5 * m[:, :, base + 2] * swiglu(hn, w13, w2)


def split_heads(t):
    return t.reshape(t.shape[:2] + (NA_HEADS, NA_HEAD_DIM))


def neighbourhood_attention(q, k, v, k_ctx, v_ctx, rpb):
    B, L, H, dh = q.shape
    R = L // GRID_W
    kh = min(NA_KH, R)
    kw = NA_KW
    scale = dh ** -0.5
    qg = q.reshape(B, R, GRID_W, H, dh)
    kg = k.reshape(B, R, GRID_W, H, dh)
    vg = v.reshape(B, R, GRID_W, H, dh)
    r = jnp.arange(R)
    row_start = jnp.clip(r - kh // 2, 0, R - kh)
    ridx = row_start[:, None] + jnp.arange(kh)[None, :]
    k_blk = kg[:, ridx]
    v_blk = vg[:, ridx]
    col = jnp.arange(GRID_W)
    col_start = jnp.clip(col - kw // 2, 0, GRID_W - kw)
    col_ok = (col[None, :] >= col_start[:, None]) & (col[None, :] < col_start[:, None] + kw)
    ri = ridx - r[:, None] + (NA_KH - 1)
    ci = jnp.clip(col[None, :] - col[:, None] + (NA_KW - 1), 0, 2 * NA_KW - 2)
    bias = rpb[:, ri[:, None, :, None], ci[None, :, None, :]].astype(jnp.float32)
    s_win = jnp.einsum('brqhd,brkwhd->bhrqkw', qg, k_blk).astype(jnp.float32) * scale + bias
    s_win = jnp.where(col_ok[:, None, :], s_win, NEG_INF)
    n_win = kh * GRID_W
    s_win = s_win.reshape(B, H, R, GRID_W, n_win)
    s_ctx = jnp.einsum('brqhd,bchd->bhrqc', qg, k_ctx).astype(jnp.float32) * scale
    p = jax.nn.softmax(jnp.concatenate([s_win, s_ctx], axis=-1), axis=-1).astype(v.dtype)
    p_win = p[..., :n_win].reshape(B, H, R, GRID_W, kh, GRID_W)
    o = (jnp.einsum('bhrqkw,brkwhd->brqhd', p_win, v_blk)
         + jnp.einsum('bhrqc,bchd->brqhd', p[..., n_win:], v_ctx))
    return o.reshape(B, L, H * dh)


def context_attention(q, k, v):
    B, C, H, dh = q.shape
    s = jnp.einsum('bqhd,bkhd->bhqk', q, k).astype(jnp.float32) * dh ** -0.5
    p = jax.nn.softmax(s, axis=-1).astype(v.dtype)
    return jnp.einsum('bhqk,bkhd->bqhd', p, v).reshape(B, C, H * dh)


def multiscale_pool(u, pool_w, pool_scale):
    B, L, _ = u.shape
    t = jnp.arange(L)
    ug = u.reshape(B, L, POOL_GROUPS, POOL_GROUP_DIM)
    outs = []
    for g, w in enumerate(POOL_WINDOWS):
        xg = ug[:, :, g].astype(jnp.float32)
        cs = jnp.pad(jnp.cumsum(xg, axis=1), ((0, 0), (1, 0), (0, 0)))
        lo = jnp.clip(t - w // 2, 0, L)
        hi = jnp.clip(t - w // 2 + w, 0, L)
        cnt = (hi - lo).astype(jnp.float32)[None, :, None]
        mean = (jnp.take(cs, hi, axis=1) - jnp.take(cs, lo, axis=1)) / cnt
        outs.append((mean - xg).astype(u.dtype) @ pool_w[g])
    return jnp.concatenate(outs, axis=-1) * pool_scale


def even_mixer(hl, hc, w_in, w_out, rpb, pool_w, pool_scale, ctx_out):
    q, k, v, u = jnp.split(hl @ w_in, [NA_WIDTH, 2 * NA_WIDTH, 3 * NA_WIDTH], axis=-1)
    k_c, v_c = jnp.split(hc @ w_in[:, NA_WIDTH:3 * NA_WIDTH], 2, axis=-1)
    k_c, v_c = split_heads(k_c), split_heads(v_c)
    att = neighbourhood_attention(split_heads(q), split_heads(k), split_heads(v), k_c, v_c, rpb)
    pool = multiscale_pool(u, pool_w, pool_scale)
    y_lat = jnp.concatenate([att, pool], axis=-1) @ w_out
    y_ctx = None
    if ctx_out:
        q_c = split_heads(hc @ w_in[:, :NA_WIDTH])
        u_c = hc @ w_in[:, 3 * NA_WIDTH:]
        att_c = context_attention(q_c, k_c, v_c)
        pool_c = multiscale_pool(u_c, pool_w, pool_scale)
        y_ctx = jnp.concatenate([att_c, pool_c], axis=-1) @ w_out
    return y_lat, y_ctx


def short_conv_mixer(h, w_in, conv_w, w_out):
    bg, cg, xin = jnp.split(h @ w_in, 3, axis=-1)
    z = cg * xin
    L = h.shape[1]
    zp = jnp.pad(z, ((0, 0), (1, 1), (0, 0)))
    y = zp[:, 0:L] * conv_w[0] + zp[:, 1:L + 1] * conv_w[1] + zp[:, 2:L + 2] * conv_w[2]
    return (bg * y) @ w_out


def setup_inputs(seed: int = 0) -> dict:
    key = jax.random.key(seed)
    ks = jax.random.split(key, 18)
    D = D_MODEL

    def nrm(k, shape, s):
        return jax.random.normal(k, shape, jnp.float32) * s

    return {
        "x": nrm(ks[0], (BATCH, SEQ, D), 1.0),
        "c": nrm(ks[1], (BATCH, D), 1.0),
        "ctx": nrm(ks[2], (BATCH, CTX_LEN, D), 1.0),
        "c_ctx": nrm(ks[3], (D,), 1.0),
        "mod_w": nrm(ks[4], (DEPTH, D, N_MOD * D), 0.5 * D ** -0.5),
        "mod_b": nrm(ks[5], (DEPTH, N_MOD * D), 0.01),
        "norm_g": 1.0 + nrm(ks[6], (DEPTH, 3, D), 0.02),
        "ffn_w13": nrm(ks[7], (DEPTH, 2, D, 2 * D_FF), D ** -0.5),
        "ffn_w2": nrm(ks[8], (DEPTH, 2, D_FF, D), D_FF ** -0.5),
        "even_w_in": nrm(ks[9], (N_EVEN, D, EVEN_IN_WIDTH), D ** -0.5),
        "even_w_out": nrm(ks[10], (N_EVEN, EVEN_MIX_WIDTH, D), EVEN_MIX_WIDTH ** -0.5),
        "na_rpb": nrm(ks[11], (N_EVEN, NA_HEADS, 2 * NA_KH - 1, 2 * NA_KW - 1), 0.1),
        "pool_w": nrm(ks[12], (N_EVEN, POOL_GROUPS, POOL_GROUP_DIM, POOL_GROUP_DIM), POOL_GROUP_DIM ** -0.5),
        "pool_scale": 1.0 + nrm(ks[13], (N_EVEN, POOL_WIDTH), 0.1),
        "conv_w_in": nrm(ks[14], (N_ODD, D, 3 * CONV_WIDTH), D ** -0.5),
        "conv_w": nrm(ks[15], (N_ODD, CONV_K, CONV_WIDTH), CONV_K ** -0.5),
        "conv_w_out": nrm(ks[16], (N_ODD, CONV_WIDTH, D), CONV_WIDTH ** -0.5),
        "final_g": 1.0 + nrm(ks[17], (D,), 0.02),
    }


def reference(x, c, ctx, c_ctx, mod_w, mod_b, norm_g, ffn_w13, ffn_w2, even_w_in, even_w_out,
              na_rpb, pool_w, pool_scale, conv_w_in, conv_w, conv_w_out, final_g):
    for i in range(DEPTH):
        even = (i % 2 == 0)
        ctx_out = any(j % 2 == 0 for j in range(i + 1, DEPTH))
        ctx_here = even or ctx_out
        m_l = adaln(c[:, None, :], mod_w[i], mod_b[i])
        m_c = adaln(c_ctx[None, None, :], mod_w[i], mod_b[i])

        x = ffn_sublayer(x, m_l, norm_g[i, 0], ffn_w13[i, 0], ffn_w2[i, 0], 0)
        if ctx_here:
            ctx = ffn_sublayer(ctx, m_c, norm_g[i, 0], ffn_w13[i, 0], ffn_w2[i, 0], 0)

        xn = modulate(rms_norm(x, norm_g[i, 1]), m_l[:, :, 3], m_l[:, :, 4])
        y_c = None
        if even:
            e = i // 2
            cn = modulate(rms_norm(ctx, norm_g[i, 1]), m_c[:, :, 3], m_c[:, :, 4])
            y_l, y_c = even_mixer(xn, cn, even_w_in[e], even_w_out[e], na_rpb[e],
                                  pool_w[e], pool_scale[e], ctx_out)
        else:
            o = i // 2
            y_l = short_conv_mixer(xn, conv_w_in[o], conv_w[o], conv_w_out[o])
            if ctx_out:
                cn = modulate(rms_norm(ctx, norm_g[i, 1]), m_c[:, :, 3], m_c[:, :, 4])
                y_c = short_conv_mixer(cn, conv_w_in[o], conv_w[o], conv_w_out[o])
        x = x + m_l[:, :, 5] * y_l

        x = ffn_sublayer(x, m_l, norm_g[i, 2], ffn_w13[i, 1], ffn_w2[i, 1], 6)
        if ctx_out:
            ctx = ctx + m_c[:, :, 5] * y_c
            ctx = ffn_sublayer(ctx, m_c, norm_g[i, 2], ffn_w13[i, 1], ffn_w2[i, 1], 6)

    return rms_norm(x, final_g)
```

```cpp
#include <hip/hip_runtime.h>
#include <cstdio>
#include <cstdint>
#include <cmath>
namespace pg8 {
#define PG8_LAS __attribute__((address_space(3)))
typedef unsigned short bf16_t;
typedef short bf16x8 __attribute__((ext_vector_type(8)));
typedef float f32x4 __attribute__((ext_vector_type(4)));
typedef unsigned u32x4 __attribute__((ext_vector_type(4)));
constexpr int BM = 256, BK = 64, HALF = 128, HTB = HALF * BK * 2  , STAGE_BYTES = 8 * HTB, NXCD = 8, WGM = 8;

__host__ __device__ __forceinline__ int lds_byte(int r, int c) { const int st = (r >> 4) * 2 + (c >> 5), rr = r & 15, cc = c & 31, ob = rr * 64 + cc * 2; return st * 1024 + (ob ^ (((ob >> 9) & 1) << 5)); }
__host__ __device__ __forceinline__ void stage_rc(int b, int& R, int& C) { const int st = b / 1024, sb = b % 1024, swz = sb ^ (((sb >> 9) & 1) << 5); R = (st >> 1) * 16 + swz / 64; C = (st & 1) * 32 + (swz % 64) / 2; }
__host__ __device__ __forceinline__ int perm32(int rho) { const int n = rho >> 4, i = rho & 15; return 8 * (i >> 2) + 4 * n + (i & 3); }

struct Unit { int pm, pn; };
struct Gemm { const bf16_t* A; const bf16_t* Bt; int M, N, K; };

struct StaticOrder {
    int nM, nN, nwg, G, c;
    __host__ __device__ void init(int M, int N, int G_, int c_) { nM = M / BM; nN = N / BM; nwg = nM * nN; G = G_; c = c_; }
    __host__ __device__ bool next(int i, Unit& u) const {
        const long L = (long)i * G + c; if (L >= nwg) return false;
        int wgid = (int)L; { const int q = nwg / NXCD, r = nwg % NXCD, xcd = wgid % NXCD, off = wgid / NXCD; wgid = (xcd < r ? xcd * (q + 1) : r * (q + 1) + (xcd - r) * q) + off; }
        const int nig = WGM * nN, gid = wgid / nig, fm = gid * WGM, gsz = (nM - fm) < WGM ? (nM - fm) : WGM;
        u.pm = fm + ((wgid % nig) % gsz); u.pn = (wgid % nig) / gsz; return true;
    }
    __device__ __forceinline__ void a_ready(const Unit&) const {}
    __device__ __forceinline__ void done(const Unit&) const {}
};

typedef float f32x2 __attribute__((ext_vector_type(2)));
typedef __bf16 bf16x2_t __attribute__((ext_vector_type(2)));
__device__ __forceinline__ unsigned cvtpk(float lo, float hi) { f32x2 v = {lo, hi}; bf16x2_t b = __builtin_convertvector(v, bf16x2_t); return __builtin_bit_cast(unsigned, b); }
__device__ __forceinline__ float silu_f(float a) { return a * __builtin_amdgcn_rcpf(1.0f + __builtin_amdgcn_exp2f(-1.4426950408889634f * a)); }

__device__ __forceinline__ void store_tile_bf16(const f32x4 (&acc)[2][2][4][2], bf16_t* O, int ldc, int row0, int col0, float sc) {
#pragma unroll
    for (int ai = 0; ai < 2; ++ai)
#pragma unroll
        for (int m = 0; m < 4; ++m) { bf16_t* rowp = O + (size_t)(row0 + ai * HALF + m * 16) * ldc + col0;
#pragma unroll
            for (int bj = 0; bj < 2; ++bj) { const f32x4 v0 = acc[ai][bj][m][0] * sc, v1 = acc[ai][bj][m][1] * sc;
                u32x4 w; w.x = cvtpk(v0[0], v0[1]); w.y = cvtpk(v0[2], v0[3]); w.z = cvtpk(v1[0], v1[1]); w.w = cvtpk(v1[2], v1[3]);
                *(u32x4*)(rowp + bj * HALF) = w; } }
}
template <bool SILU> __device__ __forceinline__ void store_tile_prod(const f32x4 (&acc)[2][2][4][2], bf16_t* O, int ldc, int row0, int col0) {
#pragma unroll
    for (int ai = 0; ai < 2; ++ai)
#pragma unroll
        for (int m = 0; m < 4; ++m) { bf16_t* rowp = O + (size_t)(row0 + ai * HALF + m * 16) * ldc + col0;
            f32x4 a0 = acc[ai][0][m][0], a1 = acc[ai][0][m][1]; const f32x4 b0 = acc[ai][1][m][0], b1 = acc[ai][1][m][1];
            if (SILU) {
#pragma unroll
                for (int e = 0; e < 4; ++e) { a0[e] = silu_f(a0[e]); a1[e] = silu_f(a1[e]); } }
            a0 = a0 * b0; a1 = a1 * b1;
            u32x4 w; w.x = cvtpk(a0[0], a0[1]); w.y = cvtpk(a0[2], a0[3]); w.z = cvtpk(a1[0], a1[1]); w.w = cvtpk(a1[2], a1[3]);
            *(u32x4*)rowp = w; }
}
struct EpiSwiGLU {
    static constexpr bool PERM = true, AFTER_DRAIN = false;
    bf16_t* H; int ldh;
    __device__ __forceinline__ void operator()(const f32x4 (&acc)[2][2][4][2], const Unit& u, int wr, int wc, int fr, int fq) const {
        store_tile_prod<true>(acc, H, ldh, u.pm * BM + wr * 64 + fr, u.pn * HALF + wc * 32 + 8 * fq);
    }
};
struct EpiResid {
    static constexpr bool PERM = false, AFTER_DRAIN = false;
    const float* base_l; const float* base_c; float* out; const float* gate_l; const float* gate_c; float coef; int Lrows, ld;
    __device__ __forceinline__ void operator()(const f32x4 (&acc)[2][2][4][2], const Unit& u, int wr, int wc, int fr, int fq) const {
        const bool isc = (u.pm * BM >= Lrows);
        const float* base = isc ? base_c : base_l; const float* gate = isc ? gate_c : gate_l;
        const int row0 = u.pm * BM + wr * 64 + fr, brow0 = isc ? row0 - Lrows : row0, col0 = u.pn * BM + wc * 32 + 4 * fq;
        f32x4 gv[2][2];
#pragma unroll
        for (int bj = 0; bj < 2; ++bj)
#pragma unroll
            for (int n = 0; n < 2; ++n) gv[bj][n] = *(const f32x4*)(gate + col0 + bj * HALF + n * 16) * coef;
#pragma unroll
        for (int ai = 0; ai < 2; ++ai)
#pragma unroll
            for (int m = 0; m < 4; ++m) { const size_t boff = (size_t)(brow0 + ai * HALF + m * 16) * ld + col0, ooff = (size_t)(row0 + ai * HALF + m * 16) * ld + col0;
#pragma unroll
                for (int bj = 0; bj < 2; ++bj)
#pragma unroll
                    for (int n = 0; n < 2; ++n) { const f32x4 b = *(const f32x4*)(base + boff + bj * HALF + n * 16);
                        *(f32x4*)(out + ooff + bj * HALF + n * 16) = b + gv[bj][n] * acc[ai][bj][m][n]; }
                if (m & 1) asm volatile("" ::: "memory"); }
    }
};
struct EpiWin {
    static constexpr bool PERM = true, AFTER_DRAIN = false;
    unsigned char* qbase; bf16_t* Vt; float qscale; int vt_ld; unsigned k_off, u_off;
    __device__ __forceinline__ void operator()(const f32x4 (&acc)[2][2][4][2], const Unit& u, int wr, int wc, int fr, int fq) const {
        const int pn = u.pn, row0 = u.pm * BM + wr * 64 + fr, lc0 = wc * 32 + 8 * fq;
        if (pn == 4 || pn == 5) {
            const int c0 = (pn - 4) * BM + lc0;
#pragma unroll
            for (int ai = 0; ai < 2; ++ai)
#pragma unroll
                for (int m = 0; m < 4; ++m) { const int tok = row0 + ai * HALF + m * 16;
#pragma unroll
                    for (int bj = 0; bj < 2; ++bj)
#pragma unroll
                        for (int n = 0; n < 2; ++n) { const f32x4 v = acc[ai][bj][m][n]; const unsigned w0 = cvtpk(v[0], v[1]), w1 = cvtpk(v[2], v[3]);
                            bf16_t* p = Vt + (size_t)(c0 + bj * HALF + 4 * n) * vt_ld + tok;
                            p[0] = (bf16_t)(w0 & 0xffffu); p[vt_ld] = (bf16_t)(w0 >> 16); p[2 * (size_t)vt_ld] = (bf16_t)(w1 & 0xffffu); p[3 * (size_t)vt_ld] = (bf16_t)(w1 >> 16); } }
        } else {
            const unsigned off = (pn >= 2 ? k_off : 0u) + (pn >= 6 ? u_off - k_off : 0u);
            bf16_t* dst = (bf16_t*)(qbase + off);
            store_tile_bf16(acc, dst, 512, row0, (pn & 1) * BM + lc0, pn < 2 ? qscale : 1.0f);
        }
    }
};
struct EpiCin {
    static constexpr bool PERM = true, AFTER_DRAIN = false;
    bf16_t *BG, *Z;
    __device__ __forceinline__ void operator()(const f32x4 (&acc)[2][2][4][2], const Unit& u, int wr, int wc, int fr, int fq) const {
        const int row0 = u.pm * BM + wr * 64 + fr, lc0 = wc * 32 + 8 * fq;
        if (u.pn < 4) store_tile_bf16(acc, BG, 1024, row0, u.pn * BM + lc0, 1.0f);
        else store_tile_prod<false>(acc, Z, 1024, row0, (u.pn - 4) * HALF + lc0);
    }
};
struct WinOrder : StaticOrder {
    __device__ bool next(int i, Unit& u) const {
        const long Lx = (long)i * G + c;
        if (Lx < nwg) return StaticOrder::next(i, u);
        if (Lx < nwg + 4) { u.pm = nM; u.pn = 2 + (int)(Lx - nwg); return true; }
        return false;
    }
};

template <class Epi, class Sched, bool ALIGN_EPI = false, bool SP2 = false>
__device__ __forceinline__ void gemm_phase(PG8_LAS unsigned char* lds, const Gemm g, const Sched& S, const Epi& E) {
    const int tid = threadIdx.x, wid = __builtin_amdgcn_readfirstlane(tid >> 6), lane = tid & 63, wr = wid >> 2, wc = wid & 3, fr = lane & 15, fq = lane >> 4;
    const int K = g.K, nt = K / BK;
    unsigned voffA[2], voffB[2];
#pragma unroll
    for (int i = 0; i < 2; ++i) { int R, C; stage_rc(tid * 16 + i * 8192, R, C); const int Rb = Epi::PERM ? ((R & ~31) + perm32(R & 31)) : R;
        voffA[i] = (unsigned)(R * K + C) * 2u; voffB[i] = (unsigned)(Rb * K + C) * 2u; }
    const size_t kstep = (size_t)(BK * 2);
    const size_t hstep = (size_t)HALF * K * 2;
    const size_t tstep = 2 * hstep;
    const unsigned ldsw = (unsigned)wid * 1024u;
    const int aoff = lds_byte(wr * 64 + fr, fq * 8), boff = lds_byte(wc * 32 + fr, fq * 8);
#define PG8_SA(b, h) (((b) * 2 + (h)) * HTB)
#define PG8_SB(b, h) ((4 + (b) * 2 + (h)) * HTB)
#define PG8_STAGE(bufoff, gbase, voff) do { _Pragma("unroll") for (int _i = 0; _i < 2; ++_i) \
        __builtin_amdgcn_global_load_lds((const unsigned*)((const char*)(gbase) + (voff)[_i]), (PG8_LAS unsigned*)(lds + (bufoff) + ldsw + _i * 8192), 16, 0, 0); } while (0)
#define PG8_LDA(dst, b, h) do { _Pragma("unroll") for (int m = 0; m < 4; ++m) _Pragma("unroll") for (int k = 0; k < 2; ++k) dst[m][k] = *(const PG8_LAS bf16x8*)(lds + PG8_SA(b, h) + aoff + m * 2048 + k * 1024); } while (0)
#define PG8_LDB(dst, b, h) do { _Pragma("unroll") for (int n = 0; n < 2; ++n) _Pragma("unroll") for (int k = 0; k < 2; ++k) dst[n][k] = *(const PG8_LAS bf16x8*)(lds + PG8_SB(b, h) + boff + n * 2048 + k * 1024); } while (0)
#define PG8_MMA(ai, bj, At, Bt) do { __builtin_amdgcn_s_setprio(1); _Pragma("unroll") for (int m = 0; m < 4; ++m) _Pragma("unroll") for (int n = 0; n < 2; ++n) _Pragma("unroll") for (int k = 0; k < 2; ++k) \
        acc[ai][bj][m][n] = __builtin_amdgcn_mfma_f32_16x16x32_bf16(Bt[n][k], At[m][k], acc[ai][bj][m][n], 0, 0, 0); __builtin_amdgcn_s_setprio(0); } while (0)
#define PG8_WAIT_V(n) asm volatile("s_waitcnt vmcnt(" #n ")" ::: "memory")
#define PG8_WAIT_L(n) asm volatile("s_waitcnt lgkmcnt(" #n ")" ::: "memory")
#define PG8_BAR __builtin_amdgcn_s_barrier()
#define PG8_SCHED __builtin_amdgcn_sched_barrier(0)
    Unit cur, nxt; int ui = 0;
    if (!S.next(0, cur)) return;
    f32x4 acc[2][2][4][2];
#pragma unroll
    for (int a = 0; a < 2; ++a)
#pragma unroll
        for (int b = 0; b < 2; ++b)
#pragma unroll
            for (int m = 0; m < 4; ++m)
#pragma unroll
                for (int n = 0; n < 2; ++n) acc[a][b][m][n] = (f32x4){0.f, 0.f, 0.f, 0.f};
    bf16x8 At[4][2], B0[2][2], B1[2][2];
    const char* cA = (const char*)g.A + (size_t)cur.pm * tstep; const char* cB = (const char*)g.Bt + (size_t)cur.pn * tstep;
    S.a_ready(cur);
    if constexpr (SP2) {
        PG8_STAGE(PG8_SB(0, 0), cB, voffB); PG8_STAGE(PG8_SB(0, 1), cB + hstep, voffB); PG8_STAGE(PG8_SA(0, 0), cA, voffA); PG8_STAGE(PG8_SA(0, 1), cA + hstep, voffA);
        if (wr == 1) PG8_BAR;
        PG8_WAIT_V(2); PG8_BAR;
        PG8_STAGE(PG8_SB(1, 0), cB + kstep, voffB); PG8_STAGE(PG8_SA(1, 0), cA + kstep, voffA); PG8_STAGE(PG8_SB(1, 1), cB + hstep + kstep, voffB);
        PG8_WAIT_V(6); PG8_BAR;
    } else {
        PG8_STAGE(PG8_SB(0, 0), cB, voffB); PG8_STAGE(PG8_SA(0, 0), cA, voffA); PG8_STAGE(PG8_SB(0, 1), cB + hstep, voffB); PG8_STAGE(PG8_SA(0, 1), cA + hstep, voffA);
        if (wr == 1) PG8_BAR;
        PG8_WAIT_V(4); PG8_BAR;
        PG8_STAGE(PG8_SB(1, 0), cB + kstep, voffB); PG8_STAGE(PG8_SA(1, 0), cA + kstep, voffA); PG8_STAGE(PG8_SB(1, 1), cB + hstep + kstep, voffB);
        PG8_WAIT_V(6); PG8_BAR;
    }
    for (;;) {
        const bool has_next = S.next(ui + 1, nxt);
        const char* nA = has_next ? (const char*)g.A + (size_t)nxt.pm * tstep : cA; const char* nB = has_next ? (const char*)g.Bt + (size_t)nxt.pn * tstep : cB;
        for (int t = 0; t < nt; t += 2) {
            const bool last = (t == nt - 2);
            const char* a1 = cA + (size_t)(t + 1) * kstep;
            const char* a2 = last ? nA : cA + (size_t)(t + 2) * kstep; const char* b2 = last ? nB : cB + (size_t)(t + 2) * kstep;
            const char* a3 = a2 + kstep; const char* b3 = b2 + kstep;
            if (last && has_next) S.a_ready(nxt);
            if constexpr (SP2) {
            PG8_LDB(B0, 0, 0); PG8_LDB(B1, 0, 1); PG8_SCHED; PG8_LDA(At, 0, 0); PG8_STAGE(PG8_SA(1, 1), a1 + hstep, voffA);
            PG8_WAIT_V(8); PG8_WAIT_L(0); PG8_BAR; PG8_MMA(0, 0, At, B0); PG8_MMA(0, 1, At, B1); PG8_BAR; PG8_SCHED;
            PG8_LDA(At, 0, 1); PG8_STAGE(PG8_SB(0, 0), b2, voffB); PG8_STAGE(PG8_SB(0, 1), b2 + hstep, voffB); PG8_STAGE(PG8_SA(0, 0), a2, voffA);
            PG8_WAIT_V(8); PG8_WAIT_L(0); PG8_BAR; PG8_MMA(1, 0, At, B0); PG8_MMA(1, 1, At, B1); PG8_BAR; PG8_SCHED;
            PG8_LDB(B0, 1, 0); PG8_LDB(B1, 1, 1); PG8_SCHED; PG8_LDA(At, 1, 0); PG8_STAGE(PG8_SA(0, 1), a2 + hstep, voffA);
            PG8_WAIT_V(8); PG8_WAIT_L(0); PG8_BAR; PG8_MMA(0, 0, At, B0); PG8_MMA(0, 1, At, B1); PG8_BAR; PG8_SCHED;
            PG8_LDA(At, 1, 1); PG8_STAGE(PG8_SB(1, 0), b3, voffB); PG8_STAGE(PG8_SB(1, 1), b3 + hstep, voffB); PG8_STAGE(PG8_SA(1, 0), a3, voffA);
            PG8_WAIT_V(8); PG8_WAIT_L(0); PG8_BAR; PG8_MMA(1, 0, At, B0); PG8_MMA(1, 1, At, B1); PG8_BAR; PG8_SCHED;
            } else {
            PG8_LDB(B0, 0, 0); PG8_SCHED; PG8_LDA(At, 0, 0); PG8_STAGE(PG8_SA(1, 1), a1 + hstep, voffA);
            PG8_WAIT_L(8); PG8_BAR; PG8_WAIT_L(0); PG8_MMA(0, 0, At, B0); PG8_BAR; PG8_SCHED;
            PG8_LDB(B1, 0, 1); PG8_STAGE(PG8_SB(0, 0), b2, voffB);
            PG8_BAR; PG8_WAIT_L(0); PG8_MMA(0, 1, At, B1); PG8_BAR;
            PG8_LDA(At, 0, 1); PG8_STAGE(PG8_SA(0, 0), a2, voffA);
            PG8_BAR; PG8_WAIT_L(0); PG8_MMA(1, 0, At, B0); PG8_BAR; PG8_SCHED;
            PG8_STAGE(PG8_SB(0, 1), b2 + hstep, voffB);
            PG8_WAIT_V(6); PG8_BAR; PG8_MMA(1, 1, At, B1); PG8_BAR;
            PG8_LDB(B0, 1, 0); PG8_SCHED; PG8_LDA(At, 1, 0); PG8_STAGE(PG8_SA(0, 1), a2 + hstep, voffA);
            PG8_WAIT_L(8); PG8_BAR; PG8_WAIT_L(0); PG8_MMA(0, 0, At, B0); PG8_BAR; PG8_SCHED;
            PG8_LDB(B1, 1, 1); PG8_STAGE(PG8_SB(1, 0), b3, voffB);
            PG8_BAR; PG8_WAIT_L(0); PG8_MMA(0, 1, At, B1); PG8_BAR;
            PG8_LDA(At, 1, 1); PG8_STAGE(PG8_SA(1, 0), a3, voffA);
            PG8_BAR; PG8_WAIT_L(0); PG8_MMA(1, 0, At, B0); PG8_BAR; PG8_SCHED;
            PG8_STAGE(PG8_SB(1, 1), b3 + hstep, voffB);
            PG8_WAIT_V(6); PG8_BAR; PG8_MMA(1, 1, At, B1); PG8_BAR;
            }
        }
        if constexpr (ALIGN_EPI) { if (wr == 0) PG8_BAR; }
        if constexpr (!Epi::AFTER_DRAIN) { E(acc, cur, wr, wc, fr, fq); S.done(cur); }
        if (!has_next) break;
#pragma unroll
        for (int a = 0; a < 2; ++a)
#pragma unroll
            for (int b = 0; b < 2; ++b)
#pragma unroll
                for (int m = 0; m < 4; ++m)
#pragma unroll
                    for (int n = 0; n < 2; ++n) acc[a][b][m][n] = (f32x4){0.f, 0.f, 0.f, 0.f};
        cur = nxt; cA = nA; cB = nB; ++ui;
        if constexpr (ALIGN_EPI) { if (wr == 1) PG8_BAR; }
    }
    PG8_WAIT_V(0);
    if constexpr (!ALIGN_EPI) { if (wr == 0) PG8_BAR; }
    PG8_BAR;
    if constexpr (Epi::AFTER_DRAIN) { E.fused(acc, cur, wr, wc, fr, fq, lds, wid, lane); S.done(cur); }
#undef PG8_SA
#undef PG8_SB
#undef PG8_STAGE
#undef PG8_LDA
#undef PG8_LDB
#undef PG8_MMA
#undef PG8_WAIT_V
#undef PG8_WAIT_L
#undef PG8_BAR
#undef PG8_SCHED
}
}
#define GAS __attribute__((address_space(1)))
#define LAS __attribute__((address_space(3)))
typedef unsigned short bf16;
typedef unsigned v4u __attribute__((ext_vector_type(4)));
typedef float f32x4 __attribute__((ext_vector_type(4)));
typedef short bf16x8 __attribute__((ext_vector_type(8)));
typedef GAS unsigned gu32;
typedef GAS unsigned long long gu64;
#define RLX_AGENT __ATOMIC_RELAXED, __HIP_MEMORY_SCOPE_AGENT
#define LDS_WAIT() asm volatile("s_waitcnt lgkmcnt(0)" ::: "memory")
#define VM_WAIT() asm volatile("s_waitcnt vmcnt(0)" ::: "memory")
__device__ __forceinline__ unsigned long long rt() { return __builtin_amdgcn_s_memrealtime(); }
__device__ __forceinline__ unsigned f2bf(float f) { unsigned u = __builtin_bit_cast(unsigned, f); return (u + 0x7fffu + ((u >> 16) & 1u)) >> 16; }
__device__ __forceinline__ unsigned pk2(float lo, float hi) { return f2bf(lo) | (f2bf(hi) << 16); }

#define XB_TMO      128
#define XB_XCNT(j)  (256  + 64 * (j))
#define XB_XSUB(j)  (1280 + 64 * (j))
#define XB_XGEN(j)  (2304 + 64 * (j))
#define XB_TOP      3328
#define XB_TOPGEN   3392
#define XCD_BAR_WORDS 3456
#define XB_SPIN_CAP (1u << 18)

__device__ __forceinline__ unsigned xb_ld(unsigned* p)              { return __hip_atomic_load(p, __ATOMIC_RELAXED, __HIP_MEMORY_SCOPE_AGENT); }
__device__ __forceinline__ unsigned xb_add(unsigned* p, unsigned v) { return __hip_atomic_fetch_add(p, v, __ATOMIC_RELAXED, __HIP_MEMORY_SCOPE_AGENT); }
__device__ __forceinline__ unsigned xb_xcc_id() { return (unsigned)__builtin_amdgcn_s_getreg((3 << 11) | 20) & 0xFu; }
#define XB_SPIN(cond, bar) do { unsigned _sp = 0; while (cond) { __builtin_amdgcn_s_sleep(1); \
    if ((++_sp & 255u) == 0u) { if (xb_ld(&(bar)[XB_TMO])) break; if (_sp > XB_SPIN_CAP) { atomicAdd(&(bar)[XB_TMO], 1u); break; } } } } while (0)

struct XcdBarrier {
    unsigned* bar; unsigned x;
    volatile LAS unsigned* st;
};

__device__ __forceinline__ XcdBarrier xcd_barrier_post(unsigned* bar, volatile LAS unsigned* st) {
    XcdBarrier b; b.bar = bar; b.x = xb_xcc_id(); b.st = st;
    if (threadIdx.x == 0) (void)xb_add(&bar[XB_XCNT(b.x)], 1u);
    return b;
}
__device__ __forceinline__ void xcd_barrier_complete(unsigned* bar, unsigned x, unsigned& nloc, unsigned& nx) {
    const unsigned G = gridDim.x * gridDim.y * gridDim.z;
    unsigned sum, cnt, mine, sp = 0u;
    for (;;) {
        sum = 0u; cnt = 0u; mine = 0u;
#pragma unroll
        for (unsigned j = 0; j < 16; ++j) { const unsigned c = xb_ld(&bar[XB_XCNT(j)]); sum += c; cnt += (c > 0u) ? 1u : 0u; mine = (j == x) ? c : mine; }
        if (sum == G) break;
        __builtin_amdgcn_s_sleep(1);
        if ((++sp & 255u) == 0u) { if (xb_ld(&bar[XB_TMO])) break; if (sp > XB_SPIN_CAP) { atomicAdd(&bar[XB_TMO], 1u); break; } }
    }
    nloc = mine > 0u ? mine : 1u; nx = cnt > 0u ? cnt : 1u;
}

__device__ __forceinline__ void xcd_barrier(const XcdBarrier& b) {
    asm volatile("s_waitcnt vmcnt(0)" ::: "memory");
    __syncthreads();
    if (threadIdx.x == 0) {
        unsigned* bar = b.bar;
        __builtin_amdgcn_s_waitcnt(0);
        unsigned nloc = b.st[0], nx = b.st[1];
        if (nloc == 0u) { xcd_barrier_complete(bar, b.x, nloc, nx); b.st[0] = nloc; b.st[1] = nx; }
        const unsigned old = xb_add(&bar[XB_XSUB(b.x)], 1u);
        const unsigned gen = old / nloc;
        if (old + 1u == (gen + 1u) * nloc) {
            __builtin_amdgcn_fence(__ATOMIC_RELEASE, "agent");
            asm volatile("s_waitcnt vmcnt(0)" ::: "memory");
            const unsigned og = xb_add(&bar[XB_TOP], 1u);
            const unsigned tg = og / nx;
            if (og + 1u == (tg + 1u) * nx) xb_add(&bar[XB_TOPGEN], 1u);
            else XB_SPIN(xb_ld(&bar[XB_TOPGEN]) == tg, bar);
            __builtin_amdgcn_fence(__ATOMIC_ACQUIRE, "agent");
            xb_add(&bar[XB_XGEN(b.x)], 1u);
            asm volatile("s_waitcnt vmcnt(0)" ::: "memory");
        } else {
            XB_SPIN(xb_ld(&bar[XB_XGEN(b.x)]) == gen, bar);
            __builtin_amdgcn_fence(__ATOMIC_ACQUIRE, "agent");
            asm volatile("s_waitcnt vmcnt(0)" ::: "memory");
        }
    }
    __syncthreads();
}
typedef unsigned u32x4 __attribute__((ext_vector_type(4)));
__device__ __forceinline__ unsigned cvtpk2(float lo, float hi) { return pg8::cvtpk(lo, hi); }

constexpr int NWAVES = 8;
constexpr int D = 1024, LSEQ = 16384, NCTX = 256, MT = LSEQ + NCTX, DFF = 2816, NMOD = 9, MODW = NMOD * D;
constexpr int GRID_W = 64, NHEADS = 8, HD = 64, NAW = 512;
constexpr float RMS_EPS = 1e-6f, LOG2E = 1.4426950408889634f;
constexpr int N_PHASES = 22;

constexpr size_t MiB = 1u << 20;
constexpr size_t WS_CTL = 0, CTL_ZERO_BYTES = 1 * MiB;
constexpr size_t WS_MOD = 1 * MiB;
constexpr size_t WS_W13T = 2 * MiB, W13T_BYTES = (size_t)2 * DFF * D * 2;
constexpr size_t WS_W2T = 46 * MiB, W2T_BYTES = (size_t)D * DFF * 2;
constexpr size_t WS_WINT = 68 * MiB, WS_WOUTT = 72 * MiB, WS_CINT = 74 * MiB, WS_COUTT = 80 * MiB;
constexpr size_t WS_XRES = 82 * MiB;
constexpr size_t WS_ACT = 147 * MiB;
constexpr size_t WS_H = 180 * MiB;
constexpr size_t WS_Q = 180 * MiB, WS_K = 196 * MiB, WS_VT = 213 * MiB, WS_U = 230 * MiB;
constexpr size_t WS_BG = 180 * MiB, WS_Z = 212 * MiB;
constexpr size_t WS_END = 270 * MiB;
static_assert(WS_W13T + 4 * W13T_BYTES <= WS_W2T && WS_W2T + 4 * W2T_BYTES <= WS_WINT && WS_XRES + (size_t)MT * D * 4 <= WS_ACT && WS_ACT + (size_t)MT * D * 2 <= WS_H && WS_H + (size_t)MT * DFF * 2 <= WS_END, "d_ws map");
static_assert(WS_K + (size_t)MT * 512 * 2 <= WS_VT && WS_VT + (size_t)MT * 512 * 2 <= WS_U && WS_U + (size_t)LSEQ * 512 * 2 <= WS_END, "mixer overlay map");
constexpr int CW_BAR = 4096;

constexpr int RING_OFF = 0, RING_BYTES = 131072;
constexpr int LDSCTL_OFF = RING_BYTES, MISC_OFF = LDSCTL_OFF + 320;
constexpr int STAB_OFF = RING_BYTES + 1024;
constexpr int LDS_BYTES = 147456;
static_assert(STAB_OFF + 8192 <= LDS_BYTES, "LDS map");

struct Frame {
    LAS unsigned char* lds;
    volatile LAS unsigned* MISC;
    gu32* ctl;
    int tid, lane, wave, vcu, G;
    const float* in[18];
    float* out; unsigned char* ws;
};
__device__ __forceinline__ float wave_sum(float v) {
#pragma unroll
    for (int o = 1; o < 64; o <<= 1) v += __shfl_xor(v, o);
    return v;
}

__device__ __forceinline__ void p0_transpose_item(const float* W, int K, int ldn, bf16* WT, int k0, int n0, int drow0, LAS float* scr, int lane) {
#pragma unroll 8
    for (int i = 0; i < 32; ++i) { const int kk = 2 * i + (lane >> 5); scr[kk * 33 + (lane & 31)] = W[(size_t)(k0 + kk) * ldn + n0 + (lane & 31)]; }
    LDS_WAIT(); asm volatile("" ::: "memory");
    const int c = lane & 7;
#pragma unroll
    for (int j = 0; j < 4; ++j) { const int n = (lane >> 3) + 8 * j; const LAS float* s = scr + (8 * c) * 33 + n;
        v4u o; o.x = pk2(s[0 * 33], s[1 * 33]); o.y = pk2(s[2 * 33], s[3 * 33]); o.z = pk2(s[4 * 33], s[5 * 33]); o.w = pk2(s[6 * 33], s[7 * 33]);
        *(GAS v4u*)(WT + (size_t)(drow0 + n) * K + k0 + 8 * c) = o; }
    LDS_WAIT(); asm volatile("" ::: "memory");
}
__device__ __forceinline__ int map_swiglu(int n0) { const int half = n0 / DFF, hx = n0 % DFF; return 256 * (hx / 128) + 128 * half + (hx % 128); }
__device__ __forceinline__ int map_cin(int n0) { if (n0 < D) return n0; const int part = (n0 - D) / D, ch = (n0 - D) % D; return D + 256 * (ch / 128) + 128 * part + (ch % 128); }

__device__ __forceinline__ void p0_prologue(Frame& F) {
    LAS float* scr = (LAS float*)(F.lds + RING_OFF + F.wave * 16384);
    LAS float* stab = (LAS float*)(F.lds + STAB_OFF);
    const int gw = F.vcu * NWAVES + F.wave, NGW = F.G * NWAVES, lane = F.lane;
    for (int k = F.tid; k < D; k += NWAVES * 64) { const float a = F.in[1][k], b = F.in[3][k]; stab[k] = a / (1.0f + expf(-a)); stab[D + k] = b / (1.0f + expf(-b)); }
    __syncthreads();
    {
        float* mv = (float*)(F.ws + WS_MOD);
        constexpr int NCH = MODW / 16;
        for (int it = gw; it < 2 * NCH; it += NGW) {
            const int layer = it / NCH, col0 = (it % NCH) * 16, cq = lane & 3, kr = lane >> 2;
            const GAS float* W = (const GAS float*)(F.in[4] + (size_t)layer * D * MODW + col0 + 4 * cq);
            f32x4 al = {0.f, 0.f, 0.f, 0.f}, ac = {0.f, 0.f, 0.f, 0.f};
#pragma unroll 8
            for (int i = 0; i < 64; ++i) { const int k = kr + 16 * i; const f32x4 w = *(const GAS f32x4*)(W + (size_t)k * MODW); al += w * stab[k]; ac += w * stab[D + k]; }
#pragma unroll
            for (int e = 0; e < 4; ++e) {
#pragma unroll
                for (int o = 4; o < 64; o <<= 1) { al[e] += __shfl_xor(al[e], o); ac[e] += __shfl_xor(ac[e], o); } }
            if (lane < 4) {
                const f32x4 b = *(const f32x4*)(F.in[5] + (size_t)layer * MODW + col0 + 4 * cq);
                if (layer == 0) { *(f32x4*)(mv + col0 + 4 * cq) = al + b; *(f32x4*)(mv + MODW + col0 + 4 * cq) = ac + b; }
                else *(f32x4*)(mv + 2 * MODW + col0 + 4 * cq) = al + b;
            }
        }
    }
    {
        bf16* WINt = (bf16*)(F.ws + WS_WINT);
        for (int it = gw; it < 4 * 64; it += NGW) {
            const int g = it >> 6, k0 = (it & 63) * 16;
#pragma unroll
            for (int i = 0; i < 32; ++i) { const int e = i * 64 + lane, kk = e >> 7, j = e & 127; scr[e] = F.in[9][(size_t)(k0 + kk) * 2048 + 1536 + g * 128 + j]; }
            LDS_WAIT(); asm volatile("" ::: "memory");
            float a0[16], a1[16];
#pragma unroll
            for (int kk = 0; kk < 16; ++kk) { a0[kk] = 0.f; a1[kk] = 0.f; }
            const GAS float* P = (const GAS float*)(F.in[12] + (size_t)g * 128 * 128);
            for (int j = 0; j < 128; ++j) {
                const float p0 = P[j * 128 + lane], p1 = P[j * 128 + 64 + lane];
#pragma unroll
                for (int kk = 0; kk < 16; ++kk) { const float a = scr[kk * 128 + j]; a0[kk] += a * p0; a1[kk] += a * p1; }
            }
            const float s0 = F.in[13][g * 128 + lane], s1 = F.in[13][g * 128 + 64 + lane];
            v4u o0, o1, o2, o3;
            o0.x = pk2(a0[0] * s0, a0[1] * s0); o0.y = pk2(a0[2] * s0, a0[3] * s0); o0.z = pk2(a0[4] * s0, a0[5] * s0); o0.w = pk2(a0[6] * s0, a0[7] * s0);
            o1.x = pk2(a0[8] * s0, a0[9] * s0); o1.y = pk2(a0[10] * s0, a0[11] * s0); o1.z = pk2(a0[12] * s0, a0[13] * s0); o1.w = pk2(a0[14] * s0, a0[15] * s0);
            o2.x = pk2(a1[0] * s1, a1[1] * s1); o2.y = pk2(a1[2] * s1, a1[3] * s1); o2.z = pk2(a1[4] * s1, a1[5] * s1); o2.w = pk2(a1[6] * s1, a1[7] * s1);
            o3.x = pk2(a1[8] * s1, a1[9] * s1); o3.y = pk2(a1[10] * s1, a1[11] * s1); o3.z = pk2(a1[12] * s1, a1[13] * s1); o3.w = pk2(a1[14] * s1, a1[15] * s1);
            GAS v4u* d0 = (GAS v4u*)(WINt + (size_t)(1536 + g * 128 + lane) * D + k0);
            GAS v4u* d1 = (GAS v4u*)(WINt + (size_t)(1536 + g * 128 + 64 + lane) * D + k0);
            d0[0] = o0; d0[1] = o1; d1[0] = o2; d1[1] = o3;
            LDS_WAIT(); asm volatile("" ::: "memory");
        }
    }
    {
        constexpr int I_13 = (D / 64) * (2 * DFF / 32), I_2 = (DFF / 64) * (D / 32), I_IN = (D / 64) * (1536 / 32), I_SQ = (D / 64) * (D / 32), I_CI = (D / 64) * (3 * D / 32);
        constexpr int NITEMS = 4 * I_13 + 4 * I_2 + I_IN + I_SQ + I_CI + I_SQ;
        for (int it = gw; it < NITEMS; it += NGW) {
            int r = it;
            if (r < 4 * I_13) { const int mi = r / I_13, q = r % I_13, nblk = 2 * DFF / 32, kb = q / nblk, nb = q % nblk;
                p0_transpose_item(F.in[7] + (size_t)mi * D * 2 * DFF, D, 2 * DFF, (bf16*)(F.ws + WS_W13T + mi * W13T_BYTES), 64 * kb, 32 * nb, map_swiglu(32 * nb), scr, lane); continue; } r -= 4 * I_13;
            if (r < 4 * I_2) { const int mi = r / I_2, q = r % I_2, nblk = D / 32, kb = q / nblk, nb = q % nblk;
                p0_transpose_item(F.in[8] + (size_t)mi * DFF * D, DFF, D, (bf16*)(F.ws + WS_W2T + mi * W2T_BYTES), 64 * kb, 32 * nb, 32 * nb, scr, lane); continue; } r -= 4 * I_2;
            if (r < I_IN) { const int nblk = 1536 / 32, kb = r / nblk, nb = r % nblk;
                p0_transpose_item(F.in[9], D, 2048, (bf16*)(F.ws + WS_WINT), 64 * kb, 32 * nb, 32 * nb, scr, lane); continue; } r -= I_IN;
            if (r < I_SQ) { const int nblk = D / 32, kb = r / nblk, nb = r % nblk;
                p0_transpose_item(F.in[10], D, D, (bf16*)(F.ws + WS_WOUTT), 64 * kb, 32 * nb, 32 * nb, scr, lane); continue; } r -= I_SQ;
            if (r < I_CI) { const int nblk = 3 * D / 32, kb = r / nblk, nb = r % nblk;
                p0_transpose_item(F.in[14], D, 3 * D, (bf16*)(F.ws + WS_CINT), 64 * kb, 32 * nb, map_cin(32 * nb), scr, lane); continue; } r -= I_CI;
            { const int nblk = D / 32, kb = r / nblk, nb = r % nblk;
                p0_transpose_item(F.in[16], D, D, (bf16*)(F.ws + WS_COUTT), 64 * kb, 32 * nb, 32 * nb, scr, lane); }
        }
    }
}

__device__ __forceinline__ void norm_rows_bf16(Frame& F, const float* src, bf16* dst, int nrows, const float* g, const float* shift, const float* scale) {
    const int gw = F.vcu * NWAVES + F.wave, NGW = F.G * NWAVES, lane = F.lane;
    f32x4 A[4], B[4];
#pragma unroll
    for (int j = 0; j < 4; ++j) { const int c = 4 * lane + 256 * j; const f32x4 gv = *(const f32x4*)(g + c), sc = *(const f32x4*)(scale + c); A[j] = gv * (sc + 1.0f); B[j] = *(const f32x4*)(shift + c); }
    for (int m = gw; m < nrows; m += NGW) {
        const GAS f32x4* xr = (const GAS f32x4*)(src + (size_t)m * D) + lane;
        f32x4 v[4]; float s2 = 0.f;
#pragma unroll
        for (int j = 0; j < 4; ++j) { v[j] = xr[64 * j]; s2 += (v[j].x * v[j].x + v[j].y * v[j].y) + (v[j].z * v[j].z + v[j].w * v[j].w); }
        const float rstd = 1.0f / sqrtf(wave_sum(s2) * (1.0f / D) + RMS_EPS);
        GAS unsigned long long* o8 = (GAS unsigned long long*)(dst + (size_t)m * D) + lane;
#pragma unroll
        for (int j = 0; j < 4; ++j) { const f32x4 y = v[j] * rstd * A[j] + B[j]; o8[64 * j] = (unsigned long long)pk2(y.x, y.y) | ((unsigned long long)pk2(y.z, y.w) << 32); }
    }
}
__device__ __forceinline__ void norm_rows_final(Frame& F, const float* src, float* dst, int nrows, const float* g) {
    const int gw = F.vcu * NWAVES + F.wave, NGW = F.G * NWAVES, lane = F.lane;
    f32x4 A[4];
#pragma unroll
    for (int j = 0; j < 4; ++j) A[j] = *(const f32x4*)(g + 4 * lane + 256 * j);
    for (int m = gw; m < nrows; m += NGW) {
        const GAS f32x4* xr = (const GAS f32x4*)(src + (size_t)m * D) + lane;
        f32x4 v[4]; float s2 = 0.f;
#pragma unroll
        for (int j = 0; j < 4; ++j) { v[j] = xr[64 * j]; s2 += (v[j].x * v[j].x + v[j].y * v[j].y) + (v[j].z * v[j].z + v[j].w * v[j].w); }
        const float rstd = 1.0f / sqrtf(wave_sum(s2) * (1.0f / D) + RMS_EPS);
        GAS f32x4* o = (GAS f32x4*)(dst + (size_t)m * D) + lane;
#pragma unroll
        for (int j = 0; j < 4; ++j) o[64 * j] = v[j] * rstd * A[j];
    }
}

typedef float f32x16 __attribute__((ext_vector_type(16)));
typedef unsigned u32x2 __attribute__((ext_vector_type(2)));
__device__ __forceinline__ int crow(int r, int hi) { return (r & 3) + 8 * (r >> 2) + 4 * hi; }
__device__ __forceinline__ float bf_lo(unsigned w) { return __uint_as_float(w << 16); }
__device__ __forceinline__ float bf_hi(unsigned w) { return __uint_as_float(w & 0xffff0000u); }

__device__ __forceinline__ void att_task(const bf16* Qb, const bf16* Kb, const bf16* Vt, bf16* Ob, const LAS float* bias, int h, int r, int ch, int lane) {
    const int q = lane & 31, hi = lane >> 5, qc = 32 * ch + q, tq = GRID_W * r + qc;
    int rs = r - 4; rs = rs < 0 ? 0 : (rs > 248 ? 248 : rs);
    int cst = qc - 8; cst = cst < 0 ? 0 : (cst > 48 ? 48 : cst);
    bf16x8 qf[4];
#pragma unroll
    for (int d0 = 0; d0 < 4; ++d0) qf[d0] = *(const GAS bf16x8*)(Qb + (size_t)tq * NAW + h * HD + d0 * 16 + 8 * hi);
    float mrun = -1e30f, lsum = 0.f;
    f32x16 o0, o1;
#pragma unroll
    for (int i = 0; i < 16; ++i) { o0[i] = 0.f; o1[i] = 0.f; }
    const LAS float* bh = bias + h * 465;
    const GAS bf16* Vh = (const GAS bf16*)(Vt + (size_t)(h * HD + q) * MT);
    for (int b = 0; b < 20; ++b) {
        const bool isw = b >= 8;
        int ktok, vb0, vb1, kr0 = 0, c16 = 0;
        if (!isw) { const int tok0 = LSEQ + 32 * b; ktok = tok0 + q; vb0 = tok0; vb1 = tok0 + 16; }
        else { const int wb = b - 8, rp = wb / 3, cc = wb - 3 * rp; kr0 = rs + 2 * rp; c16 = 16 * ch + 16 * cc; ktok = (kr0 + (q >> 4)) * GRID_W + c16 + (q & 15); vb0 = kr0 * GRID_W + c16; vb1 = vb0 + GRID_W; }
        bf16x8 kf[4];
#pragma unroll
        for (int d0 = 0; d0 < 4; ++d0) kf[d0] = *(const GAS bf16x8*)(Kb + (size_t)ktok * NAW + h * HD + d0 * 16 + 8 * hi);
        u32x2 va[2][2][2];
#pragma unroll
        for (int dh = 0; dh < 2; ++dh)
#pragma unroll
            for (int s = 0; s < 2; ++s) { const GAS bf16* p = Vh + (size_t)dh * 32 * MT + (s ? vb1 : vb0) + 4 * hi;
                va[dh][s][0] = *(const GAS u32x2*)p; va[dh][s][1] = *(const GAS u32x2*)(p + 8); }
        f32x16 S;
#pragma unroll
        for (int i = 0; i < 16; ++i) S[i] = 0.f;
#pragma unroll
        for (int d0 = 0; d0 < 4; ++d0) S = __builtin_amdgcn_mfma_f32_32x32x16_bf16(kf[d0], qf[d0], S, 0, 0, 0);
        if (isw) {
#pragma unroll
            for (int i = 0; i < 16; ++i) {
                const int kj = crow(i, hi), krow = kr0 + (kj >> 4), kc = c16 + (kj & 15);
                int ci = kc - qc + 15; ci = ci < 0 ? 0 : (ci > 30 ? 30 : ci);
                const float bv = bh[(krow - r + 7) * 31 + ci];
                S[i] = (kc >= cst && kc < cst + 16) ? S[i] + bv : -INFINITY;
            }
        }
        float bm = S[0];
#pragma unroll
        for (int i = 1; i < 16; ++i) bm = fmaxf(bm, S[i]);
        bm = fmaxf(bm, __shfl_xor(bm, 32));
        const float mn = fmaxf(mrun, bm), alpha = __builtin_amdgcn_exp2f(mrun - mn);
        mrun = mn;
        float ps = 0.f;
#pragma unroll
        for (int i = 0; i < 16; ++i) { S[i] = __builtin_amdgcn_exp2f(S[i] - mn); ps += S[i]; }
        lsum = lsum * alpha + ps;
#pragma unroll
        for (int i = 0; i < 16; ++i) { o0[i] *= alpha; o1[i] *= alpha; }
        u32x4 pw0, pw1;
        pw0.x = cvtpk2(S[0], S[1]); pw0.y = cvtpk2(S[2], S[3]); pw0.z = cvtpk2(S[4], S[5]); pw0.w = cvtpk2(S[6], S[7]);
        pw1.x = cvtpk2(S[8], S[9]); pw1.y = cvtpk2(S[10], S[11]); pw1.z = cvtpk2(S[12], S[13]); pw1.w = cvtpk2(S[14], S[15]);
        const bf16x8 pb0 = __builtin_bit_cast(bf16x8, pw0), pb1 = __builtin_bit_cast(bf16x8, pw1);
#define VFRAG(dh, s) __builtin_bit_cast(bf16x8, (u32x4){va[dh][s][0].x, va[dh][s][0].y, va[dh][s][1].x, va[dh][s][1].y})
        o0 = __builtin_amdgcn_mfma_f32_32x32x16_bf16(VFRAG(0, 0), pb0, o0, 0, 0, 0);
        o0 = __builtin_amdgcn_mfma_f32_32x32x16_bf16(VFRAG(0, 1), pb1, o0, 0, 0, 0);
        o1 = __builtin_amdgcn_mfma_f32_32x32x16_bf16(VFRAG(1, 0), pb0, o1, 0, 0, 0);
        o1 = __builtin_amdgcn_mfma_f32_32x32x16_bf16(VFRAG(1, 1), pb1, o1, 0, 0, 0);
#undef VFRAG
    }
    lsum += __shfl_xor(lsum, 32);
    const float inv = 1.0f / lsum;
    GAS bf16* orow = (GAS bf16*)(Ob + (size_t)tq * D + h * HD);
#pragma unroll
    for (int g4 = 0; g4 < 4; ++g4) {
        u32x2 w0, w1;
        w0.x = cvtpk2(o0[4 * g4] * inv, o0[4 * g4 + 1] * inv); w0.y = cvtpk2(o0[4 * g4 + 2] * inv, o0[4 * g4 + 3] * inv);
        w1.x = cvtpk2(o1[4 * g4] * inv, o1[4 * g4 + 1] * inv); w1.y = cvtpk2(o1[4 * g4 + 2] * inv, o1[4 * g4 + 3] * inv);
        *(GAS u32x2*)(orow + 8 * g4 + 4 * hi) = w0;
        *(GAS u32x2*)(orow + 32 + 8 * g4 + 4 * hi) = w1;
    }
}
__device__ __forceinline__ void pool_task(const bf16* Ub, bf16* Ob, int t0, int lane) {
    const int g = lane >> 4, hw = 1 << g;
    u32x4 rw[23];
#pragma unroll
    for (int j = 0; j < 23; ++j) { const int t = t0 - 8 + j; rw[j] = (t >= 0 && t < LSEQ) ? *(const GAS u32x4*)(Ub + (size_t)t * NAW + 8 * lane) : (u32x4){0u, 0u, 0u, 0u}; }
#pragma unroll
    for (int i = 0; i < 8; ++i) {
        const int t = t0 + i, ci = i + 8;
        int lo = t - hw; lo = lo < 0 ? 0 : lo; int hi_ = t + hw; hi_ = hi_ > LSEQ ? LSEQ : hi_;
        const float rc = 1.0f / (float)(hi_ - lo);
        u32x4 ow;
#pragma unroll
        for (int d = 0; d < 4; ++d) {
            float sl = 0.f, sh = 0.f, r1l, r1h, r2l, r2h, r4l, r4h;
#define ADDROW(j) do { sl += bf_lo(rw[j][d]); sh += bf_hi(rw[j][d]); } while (0)
            ADDROW(ci - 1); ADDROW(ci); r1l = sl; r1h = sh;
            ADDROW(ci - 2); ADDROW(ci + 1); r2l = sl; r2h = sh;
            ADDROW(ci - 4); ADDROW(ci - 3); ADDROW(ci + 2); ADDROW(ci + 3); r4l = sl; r4h = sh;
            ADDROW(ci - 8); ADDROW(ci - 7); ADDROW(ci - 6); ADDROW(ci - 5); ADDROW(ci + 4); ADDROW(ci + 5); ADDROW(ci + 6); ADDROW(ci + 7);
#undef ADDROW
            const float vl = g == 0 ? r1l : (g == 1 ? r2l : (g == 2 ? r4l : sl)), vh = g == 0 ? r1h : (g == 1 ? r2h : (g == 2 ? r4h : sh));
            ow[d] = cvtpk2(vl * rc - bf_lo(rw[ci][d]), vh * rc - bf_hi(rw[ci][d]));
        }
        *(GAS u32x4*)(Ob + (size_t)t * D + NAW + 8 * lane) = ow;
    }
}
__device__ __forceinline__ void att_phase(Frame& F) {
    LAS float* bias = (LAS float*)(F.lds + RING_OFF);
    for (int i = F.tid; i < NHEADS * 465; i += NWAVES * 64) bias[i] = F.in[11][i] * LOG2E;
    __syncthreads();
    const int gw = F.vcu * NWAVES + F.wave, NGW = F.G * NWAVES;
    const bf16* Qb = (const bf16*)(F.ws + WS_Q); const bf16* Kb = (const bf16*)(F.ws + WS_K); const bf16* Vt = (const bf16*)(F.ws + WS_VT); const bf16* Ub = (const bf16*)(F.ws + WS_U);
    bf16* Ob = (bf16*)(F.ws + WS_ACT);
    for (int T = gw; T < 4096; T += NGW) {
        const int blk = T >> 3, w8 = T & 7, x = (blk & 255) >> 5, bl = (blk & 31) + 32 * (blk >> 8);
        const int h = bl >> 3, rg = bl & 7, r = 32 * x + 4 * rg + (w8 >> 1), ch = w8 & 1;
        att_task(Qb, Kb, Vt, Ob, bias, h, r, ch, F.lane);
    }
    for (int T = gw; T < LSEQ / 8; T += NGW) pool_task(Ub, Ob, 8 * T, F.lane);
    __syncthreads();
}
__device__ __forceinline__ void conv_phase(Frame& F) {
    const int gw = F.vcu * NWAVES + F.wave, NGW = F.G * NWAVES, lane = F.lane;
    const bf16* BG = (const bf16*)(F.ws + WS_BG); const bf16* Z = (const bf16*)(F.ws + WS_Z); bf16* P = (bf16*)(F.ws + WS_ACT);
    const float* cw = F.in[15];
    for (int T = gw; T < LSEQ / 8; T += NGW) {
        const int t0 = 8 * T;
#pragma unroll
        for (int hf = 0; hf < 2; ++hf) {
            const int c0 = 512 * hf + 8 * lane;
            float w[3][8];
#pragma unroll
            for (int k = 0; k < 3; ++k) { const f32x4 a = *(const f32x4*)(cw + k * D + c0), b = *(const f32x4*)(cw + k * D + c0 + 4);
                w[k][0] = a.x; w[k][1] = a.y; w[k][2] = a.z; w[k][3] = a.w; w[k][4] = b.x; w[k][5] = b.y; w[k][6] = b.z; w[k][7] = b.w; }
            u32x4 zr[10];
#pragma unroll
            for (int j = 0; j < 10; ++j) { const int t = t0 - 1 + j; zr[j] = (t >= 0 && t < LSEQ) ? *(const GAS u32x4*)(Z + (size_t)t * D + c0) : (u32x4){0u, 0u, 0u, 0u}; }
#pragma unroll
            for (int i = 0; i < 8; ++i) {
                const u32x4 bg = *(const GAS u32x4*)(BG + (size_t)(t0 + i) * D + c0);
                u32x4 ow;
#pragma unroll
                for (int d = 0; d < 4; ++d) {
                    const float yl = w[0][2 * d] * bf_lo(zr[i][d]) + w[1][2 * d] * bf_lo(zr[i + 1][d]) + w[2][2 * d] * bf_lo(zr[i + 2][d]);
                    const float yh = w[0][2 * d + 1] * bf_hi(zr[i][d]) + w[1][2 * d + 1] * bf_hi(zr[i + 1][d]) + w[2][2 * d + 1] * bf_hi(zr[i + 2][d]);
                    ow[d] = cvtpk2(bf_lo(bg[d]) * yl, bf_hi(bg[d]) * yh);
                }
                *(GAS u32x4*)(P + (size_t)(t0 + i) * D + c0) = ow;
            }
        }
    }
}

struct Args { const float* in[18]; float* out; unsigned char* ws; int ph_lo, ph_hi; };
static_assert(sizeof(Args) == 18 * 8 + 8 + 8 + 8, "Args has no padding");

__device__ __forceinline__ void ffn_up(Frame& F, int widx, int M) {
    pg8::Gemm g{(const bf16*)(F.ws + WS_ACT), (const bf16*)(F.ws + WS_W13T + (size_t)widx * W13T_BYTES), M, 2 * DFF, D};
    pg8::StaticOrder S; S.init(M, 2 * DFF, F.G, (int)blockIdx.x);
    pg8::EpiSwiGLU E{(bf16*)(F.ws + WS_H), DFF};
    pg8::gemm_phase<pg8::EpiSwiGLU, pg8::StaticOrder, true, true>(F.lds + RING_OFF, g, S, E);
}
__device__ __forceinline__ void ffn_down(Frame& F, int widx, int M, const float* base_l, const float* base_c, const float* gate_l, const float* gate_c) {
    pg8::Gemm g{(const bf16*)(F.ws + WS_H), (const bf16*)(F.ws + WS_W2T + (size_t)widx * W2T_BYTES), M, D, DFF};
    pg8::StaticOrder S; S.init(M, D, F.G, (int)blockIdx.x);
    pg8::EpiResid E{base_l, base_c, (float*)(F.ws + WS_XRES), gate_l, gate_c, 0.5f, LSEQ, D};
    pg8::gemm_phase<pg8::EpiResid, pg8::StaticOrder, true, true>(F.lds + RING_OFF, g, S, E);
}
__device__ __forceinline__ void proj_out(Frame& F, size_t wt_off, const float* gate) {
    float* xres = (float*)(F.ws + WS_XRES);
    pg8::Gemm g{(const bf16*)(F.ws + WS_ACT), (const bf16*)(F.ws + wt_off), LSEQ, D, D};
    pg8::StaticOrder S; S.init(LSEQ, D, F.G, (int)blockIdx.x);
    pg8::EpiResid E{xres, xres, xres, gate, gate, 1.0f, LSEQ, D};
    pg8::gemm_phase<pg8::EpiResid, pg8::StaticOrder, true, true>(F.lds + RING_OFF, g, S, E);
}

__global__ void __launch_bounds__(NWAVES * 64, 2) mk_fwd(Args args) {
    extern __shared__ __attribute__((aligned(16))) unsigned char lds[];
    Frame F;
    F.lds = (LAS unsigned char*)lds;
    F.MISC = (volatile LAS unsigned*)(F.lds + MISC_OFF);
    F.tid = threadIdx.x; F.lane = F.tid & 63; F.wave = __builtin_amdgcn_readfirstlane(F.tid >> 6);
    F.G = gridDim.x; { const int bx = blockIdx.x; F.vcu = (F.G % 8 == 0) ? (bx % 8) * (F.G / 8) + bx / 8 : bx; }
    F.ws = args.ws; F.out = args.out; F.ctl = (gu32*)(args.ws + WS_CTL);
#pragma unroll
    for (int i = 0; i < 18; ++i) F.in[i] = args.in[i];
    for (int u = F.tid; u < (LDS_BYTES - LDSCTL_OFF) / 4; u += NWAVES * 64) ((LAS unsigned*)(F.lds + LDSCTL_OFF))[u] = 0u;
    __syncthreads();
    const int lo = args.ph_lo, hi = args.ph_hi;
    const bool multi = (hi - lo) > 1;
    XcdBarrier bar; bar.bar = (unsigned*)(F.ctl + CW_BAR); bar.x = 0; bar.st = nullptr;
    if (multi) bar = xcd_barrier_post((unsigned*)(F.ctl + CW_BAR), F.MISC + 8);
#define IN(k) (lo <= (k) && (k) < hi)
#define SEAM(k) do { if (IN(k) && IN((k) + 1)) xcd_barrier(bar); } while (0)
    const float* mv = (const float*)(F.ws + WS_MOD);
    const float* ml0 = mv; const float* mc0 = mv + MODW; const float* ml1 = mv + 2 * MODW;
    float* xres = (float*)(F.ws + WS_XRES);
    bf16* act = (bf16*)(F.ws + WS_ACT);
    const float* ng = F.in[6];

    if (IN(0)) { p0_prologue(F); } SEAM(0);
    if (IN(1)) { norm_rows_bf16(F, F.in[0], act, LSEQ, ng + 0 * D, ml0 + 0 * D, ml0 + 1 * D);
                 norm_rows_bf16(F, F.in[2], act + (size_t)LSEQ * D, NCTX, ng + 0 * D, mc0 + 0 * D, mc0 + 1 * D); } SEAM(1);
    if (IN(2)) { ffn_up(F, 0, MT); } SEAM(2);
    if (IN(3)) { ffn_down(F, 0, MT, F.in[0], F.in[2], ml0 + 2 * D, mc0 + 2 * D); } SEAM(3);
    if (IN(4)) { norm_rows_bf16(F, xres, act, LSEQ, ng + 1 * D, ml0 + 3 * D, ml0 + 4 * D);
                 norm_rows_bf16(F, xres + (size_t)LSEQ * D, act + (size_t)LSEQ * D, NCTX, ng + 1 * D, mc0 + 3 * D, mc0 + 4 * D); } SEAM(4);
    if (IN(5)) {
        pg8::Gemm g{(const bf16*)act, (const bf16*)(F.ws + WS_WINT), LSEQ, 2048, D};
        pg8::WinOrder S; S.init(LSEQ, 2048, F.G, (int)blockIdx.x);
        pg8::EpiWin E{F.ws + WS_Q, (bf16*)(F.ws + WS_VT), 0.125f * LOG2E, MT, (unsigned)(WS_K - WS_Q), (unsigned)(WS_U - WS_Q)};
        pg8::gemm_phase<pg8::EpiWin, pg8::WinOrder, true, true>(F.lds + RING_OFF, g, S, E);
    } SEAM(5);
    if (IN(6)) { att_phase(F); } SEAM(6);
    if (IN(7)) { proj_out(F, WS_WOUTT, ml0 + 5 * D); } SEAM(7);
    if (IN(8)) { norm_rows_bf16(F, xres, act, LSEQ, ng + 2 * D, ml0 + 6 * D, ml0 + 7 * D); } SEAM(8);
    if (IN(9)) { ffn_up(F, 1, LSEQ); } SEAM(9);
    if (IN(10)) { ffn_down(F, 1, LSEQ, xres, xres, ml0 + 8 * D, ml0 + 8 * D); } SEAM(10);
    if (IN(11)) { norm_rows_bf16(F, xres, act, LSEQ, ng + 3 * D, ml1 + 0 * D, ml1 + 1 * D); } SEAM(11);
    if (IN(12)) { ffn_up(F, 2, LSEQ); } SEAM(12);
    if (IN(13)) { ffn_down(F, 2, LSEQ, xres, xres, ml1 + 2 * D, ml1 + 2 * D); } SEAM(13);
    if (IN(14)) { norm_rows_bf16(F, xres, act, LSEQ, ng + 4 * D, ml1 + 3 * D, ml1 + 4 * D); } SEAM(14);
    if (IN(15)) {
        pg8::Gemm g{(const bf16*)act, (const bf16*)(F.ws + WS_CINT), LSEQ, 3 * D, D};
        pg8::StaticOrder S; S.init(LSEQ, 3 * D, F.G, (int)blockIdx.x);
        pg8::EpiCin E{(bf16*)(F.ws + WS_BG), (bf16*)(F.ws + WS_Z)};
        pg8::gemm_phase<pg8::EpiCin, pg8::StaticOrder, true, true>(F.lds + RING_OFF, g, S, E);
    } SEAM(15);
    if (IN(16)) { conv_phase(F); } SEAM(16);
    if (IN(17)) { proj_out(F, WS_COUTT, ml1 + 5 * D); } SEAM(17);
    if (IN(18)) { norm_rows_bf16(F, xres, act, LSEQ, ng + 5 * D, ml1 + 6 * D, ml1 + 7 * D); } SEAM(18);
    if (IN(19)) { ffn_up(F, 3, LSEQ); } SEAM(19);
    if (IN(20)) { ffn_down(F, 3, LSEQ, xres, xres, ml1 + 8 * D, ml1 + 8 * D); } SEAM(20);
    if (IN(21)) { norm_rows_final(F, xres, F.out, LSEQ, F.in[17]); }
#undef IN
#undef SEAM
}

#ifndef MK_PER_PHASE
#define MK_PER_PHASE 1
#endif
extern "C" void kernel_launch(void* const* d_in, const int* in_sizes, int n_in, void* d_out, int out_size, void* d_ws, size_t ws_size, hipStream_t stream) {
    static int grid = 0;
    if (grid == 0) {
        if (n_in != 18 || in_sizes[0] != LSEQ * D || out_size != LSEQ * D || ws_size < WS_END) { fprintf(stderr, "kernel_launch: shape/workspace mismatch (n_in %d, in0 %d, out %d, ws %zu)\n", n_in, n_in > 0 ? in_sizes[0] : -1, out_size, ws_size); grid = -1; return; }
        int dev = 0, cus = 0;
        if (hipGetDevice(&dev) != hipSuccess || hipDeviceGetAttribute(&cus, hipDeviceAttributeMultiprocessorCount, dev) != hipSuccess) { grid = -1; return; }
        if (hipFuncSetAttribute((const void*)mk_fwd, hipFuncAttributeMaxDynamicSharedMemorySize, LDS_BYTES) != hipSuccess) { fprintf(stderr, "kernel_launch: hipFuncSetAttribute failed\n"); grid = -1; return; }
        (void)hipGetLastError();
        grid = cus;
    }
    if (grid < 0) return;
    if (hipMemsetAsync((char*)d_ws + WS_CTL, 0, CTL_ZERO_BYTES, stream) != hipSuccess) return;
    Args a{};
    for (int i = 0; i < 18; ++i) a.in[i] = (const float*)d_in[i];
    a.out = (float*)d_out; a.ws = (unsigned char*)d_ws;
#if MK_PER_PHASE
    for (int p = 0; p < N_PHASES; ++p) { a.ph_lo = p; a.ph_hi = p + 1; hipLaunchKernelGGL(mk_fwd, dim3(grid), dim3(NWAVES * 64), LDS_BYTES, stream, a); }
#else
    a.ph_lo = 0; a.ph_hi = N_PHASES; hipLaunchKernelGGL(mk_fwd, dim3(grid), dim3(NWAVES * 64), LDS_BYTES, stream, a);
#endif
}
```

```cpp
#include <hip/hip_runtime.h>
#include <cstdio>
#include <cstdint>
#include <cmath>
namespace pg8 {
#define PG8_LAS __attribute__((address_space(3)))
typedef unsigned short bf16_t;
typedef short bf16x8 __attribute__((ext_vector_type(8)));
typedef float f32x4 __attribute__((ext_vector_type(4)));
typedef unsigned u32x4 __attribute__((ext_vector_type(4)));
constexpr int BM = 256, BK = 64, HALF = 128, HTB = HALF * BK * 2  , STAGE_BYTES = 8 * HTB, NXCD = 8, WGM = 8;

__host__ __device__ __forceinline__ int lds_byte(int r, int c) { const int st = (r >> 4) * 2 + (c >> 5), rr = r & 15, cc = c & 31, ob = rr * 64 + cc * 2; return st * 1024 + (ob ^ (((ob >> 9) & 1) << 5)); }
__host__ __device__ __forceinline__ void stage_rc(int b, int& R, int& C) { const int st = b / 1024, sb = b % 1024, swz = sb ^ (((sb >> 9) & 1) << 5); R = (st >> 1) * 16 + swz / 64; C = (st & 1) * 32 + (swz % 64) / 2; }
__host__ __device__ __forceinline__ int perm32(int rho) { const int n = rho >> 4, i = rho & 15; return 8 * (i >> 2) + 4 * n + (i & 3); }

struct Unit { int pm, pn; };
struct Gemm { const bf16_t* A; const bf16_t* Bt; int M, N, K; };

struct StaticOrder {
    int nM, nN, nwg, G, c;
    __host__ __device__ void init(int M, int N, int G_, int c_) { nM = M / BM; nN = N / BM; nwg = nM * nN; G = G_; c = c_; }
    __host__ __device__ bool next(int i, Unit& u) const {
        const long L = (long)i * G + c; if (L >= nwg) return false;
        int wgid = (int)L; { const int q = nwg / NXCD, r = nwg % NXCD, xcd = wgid % NXCD, off = wgid / NXCD; wgid = (xcd < r ? xcd * (q + 1) : r * (q + 1) + (xcd - r) * q) + off; }
        const int nig = WGM * nN, gid = wgid / nig, fm = gid * WGM, gsz = (nM - fm) < WGM ? (nM - fm) : WGM;
        u.pm = fm + ((wgid % nig) % gsz); u.pn = (wgid % nig) / gsz; return true;
    }
    __device__ __forceinline__ void a_ready(const Unit&) const {}
    __device__ __forceinline__ void done(const Unit&) const {}
};

typedef float f32x2 __attribute__((ext_vector_type(2)));
typedef __bf16 bf16x2_t __attribute__((ext_vector_type(2)));
__device__ __forceinline__ unsigned cvtpk(float lo, float hi) { f32x2 v = {lo, hi}; bf16x2_t b = __builtin_convertvector(v, bf16x2_t); return __builtin_bit_cast(unsigned, b); }
__device__ __forceinline__ float silu_f(float a) { return a * __builtin_amdgcn_rcpf(1.0f + __builtin_amdgcn_exp2f(-1.4426950408889634f * a)); }

__device__ __forceinline__ void store_tile_bf16(const f32x4 (&acc)[2][2][4][2], bf16_t* O, int ldc, int row0, int col0, float sc) {
#pragma unroll
    for (int ai = 0; ai < 2; ++ai)
#pragma unroll
        for (int m = 0; m < 4; ++m) { bf16_t* rowp = O + (size_t)(row0 + ai * HALF + m * 16) * ldc + col0;
#pragma unroll
            for (int bj = 0; bj < 2; ++bj) { const f32x4 v0 = acc[ai][bj][m][0] * sc, v1 = acc[ai][bj][m][1] * sc;
                u32x4 w; w.x = cvtpk(v0[0], v0[1]); w.y = cvtpk(v0[2], v0[3]); w.z = cvtpk(v1[0], v1[1]); w.w = cvtpk(v1[2], v1[3]);
                *(u32x4*)(rowp + bj * HALF) = w; } }
}
template <bool SILU> __device__ __forceinline__ void store_tile_prod(const f32x4 (&acc)[2][2][4][2], bf16_t* O, int ldc, int row0, int col0) {
#pragma unroll
    for (int ai = 0; ai < 2; ++ai)
#pragma unroll
        for (int m = 0; m < 4; ++m) { bf16_t* rowp = O + (size_t)(row0 + ai * HALF + m * 16) * ldc + col0;
            f32x4 a0 = acc[ai][0][m][0], a1 = acc[ai][0][m][1]; const f32x4 b0 = acc[ai][1][m][0], b1 = acc[ai][1][m][1];
            if (SILU) {
#pragma unroll
                for (int e = 0; e < 4; ++e) { a0[e] = silu_f(a0[e]); a1[e] = silu_f(a1[e]); } }
            a0 = a0 * b0; a1 = a1 * b1;
            u32x4 w; w.x = cvtpk(a0[0], a0[1]); w.y = cvtpk(a0[2], a0[3]); w.z = cvtpk(a1[0], a1[1]); w.w = cvtpk(a1[2], a1[3]);
            *(u32x4*)rowp = w; }
}
struct EpiSwiGLU {
    static constexpr bool PERM = true, AFTER_DRAIN = false;
    bf16_t* H; int ldh;
    __device__ __forceinline__ void operator()(const f32x4 (&acc)[2][2][4][2], const Unit& u, int wr, int wc, int fr, int fq) const {
        store_tile_prod<true>(acc, H, ldh, u.pm * BM + wr * 64 + fr, u.pn * HALF + wc * 32 + 8 * fq);
    }
};
struct EpiResid {
    static constexpr bool PERM = false, AFTER_DRAIN = false;
    const float* base_l; const float* base_c; float* out; const float* gate_l; const float* gate_c; float coef; int Lrows, ld;
    __device__ __forceinline__ void operator()(const f32x4 (&acc)[2][2][4][2], const Unit& u, int wr, int wc, int fr, int fq) const {
        const bool isc = (u.pm * BM >= Lrows);
        const float* base = isc ? base_c : base_l; const float* gate = isc ? gate_c : gate_l;
        const int row0 = u.pm * BM + wr * 64 + fr, brow0 = isc ? row0 - Lrows : row0, col0 = u.pn * BM + wc * 32 + 4 * fq;
        f32x4 gv[2][2];
#pragma unroll
        for (int bj = 0; bj < 2; ++bj)
#pragma unroll
            for (int n = 0; n < 2; ++n) gv[bj][n] = *(const f32x4*)(gate + col0 + bj * HALF + n * 16) * coef;
#pragma unroll
        for (int ai = 0; ai < 2; ++ai)
#pragma unroll
            for (int m = 0; m < 4; ++m) { const size_t boff = (size_t)(brow0 + ai * HALF + m * 16) * ld + col0, ooff = (size_t)(row0 + ai * HALF + m * 16) * ld + col0;
#pragma unroll
                for (int bj = 0; bj < 2; ++bj)
#pragma unroll
                    for (int n = 0; n < 2; ++n) { const f32x4 b = *(const f32x4*)(base + boff + bj * HALF + n * 16);
                        *(f32x4*)(out + ooff + bj * HALF + n * 16) = b + gv[bj][n] * acc[ai][bj][m][n]; }
                if (m & 1) asm volatile("" ::: "memory"); }
    }
};
struct EpiWin {
    static constexpr bool PERM = true, AFTER_DRAIN = false;
    unsigned char* qbase; bf16_t* Vt; float qscale; int vt_ld; unsigned k_off, u_off;
    __device__ __forceinline__ void operator()(const f32x4 (&acc)[2][2][4][2], const Unit& u, int wr, int wc, int fr, int fq) const {
        const int pn = u.pn, row0 = u.pm * BM + wr * 64 + fr, lc0 = wc * 32 + 8 * fq;
        if (pn == 4 || pn == 5) {
            const int c0 = (pn - 4) * BM + lc0;
#pragma unroll
            for (int ai = 0; ai < 2; ++ai)
#pragma unroll
                for (int m = 0; m < 4; ++m) { const int tok = row0 + ai * HALF + m * 16;
#pragma unroll
                    for (int bj = 0; bj < 2; ++bj)
#pragma unroll
                        for (int n = 0; n < 2; ++n) { const f32x4 v = acc[ai][bj][m][n]; const unsigned w0 = cvtpk(v[0], v[1]), w1 = cvtpk(v[2], v[3]);
                            bf16_t* p = Vt + (size_t)(c0 + bj * HALF + 4 * n) * vt_ld + tok;
                            p[0] = (bf16_t)(w0 & 0xffffu); p[vt_ld] = (bf16_t)(w0 >> 16); p[2 * (size_t)vt_ld] = (bf16_t)(w1 & 0xffffu); p[3 * (size_t)vt_ld] = (bf16_t)(w1 >> 16); } }
        } else {
            const unsigned off = (pn >= 2 ? k_off : 0u) + (pn >= 6 ? u_off - k_off : 0u);
            bf16_t* dst = (bf16_t*)(qbase + off);
            store_tile_bf16(acc, dst, 512, row0, (pn & 1) * BM + lc0, pn < 2 ? qscale : 1.0f);
        }
    }
};
struct EpiCin {
    static constexpr bool PERM = true, AFTER_DRAIN = false;
    bf16_t *BG, *Z;
    __device__ __forceinline__ void operator()(const f32x4 (&acc)[2][2][4][2], const Unit& u, int wr, int wc, int fr, int fq) const {
        const int row0 = u.pm * BM + wr * 64 + fr, lc0 = wc * 32 + 8 * fq;
        if (u.pn < 4) store_tile_bf16(acc, BG, 1024, row0, u.pn * BM + lc0, 1.0f);
        else store_tile_prod<false>(acc, Z, 1024, row0, (u.pn - 4) * HALF + lc0);
    }
};
struct WinOrder : StaticOrder {
    __device__ bool next(int i, Unit& u) const {
        const long Lx = (long)i * G + c;
        if (Lx < nwg) return StaticOrder::next(i, u);
        if (Lx < nwg + 4) { u.pm = nM; u.pn = 2 + (int)(Lx - nwg); return true; }
        return false;
    }
};

template <class Epi, class Sched, bool ALIGN_EPI = false, bool SP2 = false>
__device__ __forceinline__ void gemm_phase(PG8_LAS unsigned char* lds, const Gemm g, const Sched& S, const Epi& E) {
    const int tid = threadIdx.x, wid = __builtin_amdgcn_readfirstlane(tid >> 6), lane = tid & 63, wr = wid >> 2, wc = wid & 3, fr = lane & 15, fq = lane >> 4;
    const int K = g.K, nt = K / BK;
    unsigned voffA[2], voffB[2];
#pragma unroll
    for (int i = 0; i < 2; ++i) { int R, C; stage_rc(tid * 16 + i * 8192, R, C); const int Rb = Epi::PERM ? ((R & ~31) + perm32(R & 31)) : R;
        voffA[i] = (unsigned)(R * K + C) * 2u; voffB[i] = (unsigned)(Rb * K + C) * 2u; }
    const size_t kstep = (size_t)(BK * 2);
    const size_t hstep = (size_t)HALF * K * 2;
    const size_t tstep = 2 * hstep;
    const unsigned ldsw = (unsigned)wid * 1024u;
    const int aoff = lds_byte(wr * 64 + fr, fq * 8), boff = lds_byte(wc * 32 + fr, fq * 8);
#define PG8_SA(b, h) (((b) * 2 + (h)) * HTB)
#define PG8_SB(b, h) ((4 + (b) * 2 + (h)) * HTB)
#define PG8_STAGE(bufoff, gbase, voff) do { _Pragma("unroll") for (int _i = 0; _i < 2; ++_i) \
        __builtin_amdgcn_global_load_lds((const unsigned*)((const char*)(gbase) + (voff)[_i]), (PG8_LAS unsigned*)(lds + (bufoff) + ldsw + _i * 8192), 16, 0, 0); } while (0)
#define PG8_LDA(dst, b, h) do { _Pragma("unroll") for (int m = 0; m < 4; ++m) _Pragma("unroll") for (int k = 0; k < 2; ++k) dst[m][k] = *(const PG8_LAS bf16x8*)(lds + PG8_SA(b, h) + aoff + m * 2048 + k * 1024); } while (0)
#define PG8_LDB(dst, b, h) do { _Pragma("unroll") for (int n = 0; n < 2; ++n) _Pragma("unroll") for (int k = 0; k < 2; ++k) dst[n][k] = *(const PG8_LAS bf16x8*)(lds + PG8_SB(b, h) + boff + n * 2048 + k * 1024); } while (0)
#define PG8_MMA(ai, bj, At, Bt) do { __builtin_amdgcn_s_setprio(1); _Pragma("unroll") for (int m = 0; m < 4; ++m) _Pragma("unroll") for (int n = 0; n < 2; ++n) _Pragma("unroll") for (int k = 0; k < 2; ++k) \
        acc[ai][bj][m][n] = __builtin_amdgcn_mfma_f32_16x16x32_bf16(Bt[n][k], At[m][k], acc[ai][bj][m][n], 0, 0, 0); __builtin_amdgcn_s_setprio(0); } while (0)
#define PG8_WAIT_V(n) asm volatile("s_waitcnt vmcnt(" #n ")" ::: "memory")
#define PG8_WAIT_L(n) asm volatile("s_waitcnt lgkmcnt(" #n ")" ::: "memory")
#define PG8_BAR __builtin_amdgcn_s_barrier()
#define PG8_SCHED __builtin_amdgcn_sched_barrier(0)
    Unit cur, nxt; int ui = 0;
    if (!S.next(0, cur)) return;
    f32x4 acc[2][2][4][2];
#pragma unroll
    for (int a = 0; a < 2; ++a)
#pragma unroll
        for (int b = 0; b < 2; ++b)
#pragma unroll
            for (int m = 0; m < 4; ++m)
#pragma unroll
                for (int n = 0; n < 2; ++n) acc[a][b][m][n] = (f32x4){0.f, 0.f, 0.f, 0.f};
    bf16x8 At[4][2], B0[2][2], B1[2][2];
    const char* cA = (const char*)g.A + (size_t)cur.pm * tstep; const char* cB = (const char*)g.Bt + (size_t)cur.pn * tstep;
    S.a_ready(cur);
    if constexpr (SP2) {
        PG8_STAGE(PG8_SB(0, 0), cB, voffB); PG8_STAGE(PG8_SB(0, 1), cB + hstep, voffB); PG8_STAGE(PG8_SA(0, 0), cA, voffA); PG8_STAGE(PG8_SA(0, 1), cA + hstep, voffA);
        if (wr == 1) PG8_BAR;
        PG8_WAIT_V(2); PG8_BAR;
        PG8_STAGE(PG8_SB(1, 0), cB + kstep, voffB); PG8_STAGE(PG8_SA(1, 0), cA + kstep, voffA); PG8_STAGE(PG8_SB(1, 1), cB + hstep + kstep, voffB);
        PG8_WAIT_V(6); PG8_BAR;
    } else {
        PG8_STAGE(PG8_SB(0, 0), cB, voffB); PG8_STAGE(PG8_SA(0, 0), cA, voffA); PG8_STAGE(PG8_SB(0, 1), cB + hstep, voffB); PG8_STAGE(PG8_SA(0, 1), cA + hstep, voffA);
        if (wr == 1) PG8_BAR;
        PG8_WAIT_V(4); PG8_BAR;
        PG8_STAGE(PG8_SB(1, 0), cB + kstep, voffB); PG8_STAGE(PG8_SA(1, 0), cA + kstep, voffA); PG8_STAGE(PG8_SB(1, 1), cB + hstep + kstep, voffB);
        PG8_WAIT_V(6); PG8_BAR;
    }
    for (;;) {
        const bool has_next = S.next(ui + 1, nxt);
        const char* nA = has_next ? (const char*)g.A + (size_t)nxt.pm * tstep : cA; const char* nB = has_next ? (const char*)g.Bt + (size_t)nxt.pn * tstep : cB;
        for (int t = 0; t < nt; t += 2) {
            const bool last = (t == nt - 2);
            const char* a1 = cA + (size_t)(t + 1) * kstep;
            const char* a2 = last ? nA : cA + (size_t)(t + 2) * kstep; const char* b2 = last ? nB : cB + (size_t)(t + 2) * kstep;
            const char* a3 = a2 + kstep; const char* b3 = b2 + kstep;
            if (last && has_next) S.a_ready(nxt);
            if constexpr (SP2) {
            PG8_LDB(B0, 0, 0); PG8_LDB(B1, 0, 1); PG8_SCHED; PG8_LDA(At, 0, 0); PG8_STAGE(PG8_SA(1, 1), a1 + hstep, voffA);
            PG8_WAIT_V(8); PG8_WAIT_L(0); PG8_BAR; PG8_MMA(0, 0, At, B0); PG8_MMA(0, 1, At, B1); PG8_BAR; PG8_SCHED;
            PG8_LDA(At, 0, 1); PG8_STAGE(PG8_SB(0, 0), b2, voffB); PG8_STAGE(PG8_SB(0, 1), b2 + hstep, voffB); PG8_STAGE(PG8_SA(0, 0), a2, voffA);
            PG8_WAIT_V(8); PG8_WAIT_L(0); PG8_BAR; PG8_MMA(1, 0, At, B0); PG8_MMA(1, 1, At, B1); PG8_BAR; PG8_SCHED;
            PG8_LDB(B0, 1, 0); PG8_LDB(B1, 1, 1); PG8_SCHED; PG8_LDA(At, 1, 0); PG8_STAGE(PG8_SA(0, 1), a2 + hstep, voffA);
            PG8_WAIT_V(8); PG8_WAIT_L(0); PG8_BAR; PG8_MMA(0, 0, At, B0); PG8_MMA(0, 1, At, B1); PG8_BAR; PG8_SCHED;
            PG8_LDA(At, 1, 1); PG8_STAGE(PG8_SB(1, 0), b3, voffB); PG8_STAGE(PG8_SB(1, 1), b3 + hstep, voffB); PG8_STAGE(PG8_SA(1, 0), a3, voffA);
            PG8_WAIT_V(8); PG8_WAIT_L(0); PG8_BAR; PG8_MMA(1, 0, At, B0); PG8_MMA(1, 1, At, B1); PG8_BAR; PG8_SCHED;
            } else {
            PG8_LDB(B0, 0, 0); PG8_SCHED; PG8_LDA(At, 0, 0); PG8_STAGE(PG8_SA(1, 1), a1 + hstep, voffA);
            PG8_WAIT_L(8); PG8_BAR; PG8_WAIT_L(0); PG8_MMA(0, 0, At, B0); PG8_BAR; PG8_SCHED;
            PG8_LDB(B1, 0, 1); PG8_STAGE(PG8_SB(0, 0), b2, voffB);
            PG8_BAR; PG8_WAIT_L(0); PG8_MMA(0, 1, At, B1); PG8_BAR;
            PG8_LDA(At, 0, 1); PG8_STAGE(PG8_SA(0, 0), a2, voffA);
            PG8_BAR; PG8_WAIT_L(0); PG8_MMA(1, 0, At, B0); PG8_BAR; PG8_SCHED;
            PG8_STAGE(PG8_SB(0, 1), b2 + hstep, voffB);
            PG8_WAIT_V(6); PG8_BAR; PG8_MMA(1, 1, At, B1); PG8_BAR;
            PG8_LDB(B0, 1, 0); PG8_SCHED; PG8_LDA(At, 1, 0); PG8_STAGE(PG8_SA(0, 1), a2 + hstep, voffA);
            PG8_WAIT_L(8); PG8_BAR; PG8_WAIT_L(0); PG8_MMA(0, 0, At, B0); PG8_BAR; PG8_SCHED;
            PG8_LDB(B1, 1, 1); PG8_STAGE(PG8_SB(1, 0), b3, voffB);
            PG8_BAR; PG8_WAIT_L(0); PG8_MMA(0, 1, At, B1); PG8_BAR;
            PG8_LDA(At, 1, 1); PG8_STAGE(PG8_SA(1, 0), a3, voffA);
            PG8_BAR; PG8_WAIT_L(0); PG8_MMA(1, 0, At, B0); PG8_BAR; PG8_SCHED;
            PG8_STAGE(PG8_SB(1, 1), b3 + hstep, voffB);
            PG8_WAIT_V(6); PG8_BAR; PG8_MMA(1, 1, At, B1); PG8_BAR;
            }
        }
        if constexpr (ALIGN_EPI) { if (wr == 0) PG8_BAR; }
        if constexpr (!Epi::AFTER_DRAIN) { E(acc, cur, wr, wc, fr, fq); S.done(cur); }
        if (!has_next) break;
#pragma unroll
        for (int a = 0; a < 2; ++a)
#pragma unroll
            for (int b = 0; b < 2; ++b)
#pragma unroll
                for (int m = 0; m < 4; ++m)
#pragma unroll
                    for (int n = 0; n < 2; ++n) acc[a][b][m][n] = (f32x4){0.f, 0.f, 0.f, 0.f};
        cur = nxt; cA = nA; cB = nB; ++ui;
        if constexpr (ALIGN_EPI) { if (wr == 1) PG8_BAR; }
    }
    PG8_WAIT_V(0);
    if constexpr (!ALIGN_EPI) { if (wr == 0) PG8_BAR; }
    PG8_BAR;
    if constexpr (Epi::AFTER_DRAIN) { E.fused(acc, cur, wr, wc, fr, fq, lds, wid, lane); S.done(cur); }
#undef PG8_SA
#undef PG8_SB
#undef PG8_STAGE
#undef PG8_LDA
#undef PG8_LDB
#undef PG8_MMA
#undef PG8_WAIT_V
#undef PG8_WAIT_L
#undef PG8_BAR
#undef PG8_SCHED
}
}
#define GAS __attribute__((address_space(1)))
#define LAS __attribute__((address_space(3)))
typedef unsigned short bf16;
typedef unsigned v4u __attribute__((ext_vector_type(4)));
typedef float f32x4 __attribute__((ext_vector_type(4)));
typedef short bf16x8 __attribute__((ext_vector_type(8)));
typedef GAS unsigned gu32;
typedef GAS unsigned long long gu64;
#define RLX_AGENT __ATOMIC_RELAXED, __HIP_MEMORY_SCOPE_AGENT
#define LDS_WAIT() asm volatile("s_waitcnt lgkmcnt(0)" ::: "memory")
#define VM_WAIT() asm volatile("s_waitcnt vmcnt(0)" ::: "memory")
__device__ __forceinline__ unsigned long long rt() { return __builtin_amdgcn_s_memrealtime(); }
__device__ __forceinline__ unsigned f2bf(float f) { unsigned u = __builtin_bit_cast(unsigned, f); return (u + 0x7fffu + ((u >> 16) & 1u)) >> 16; }
__device__ __forceinline__ unsigned pk2(float lo, float hi) { return f2bf(lo) | (f2bf(hi) << 16); }

#define XB_TMO      128
#define XB_XCNT(j)  (256  + 64 * (j))
#define XB_XSUB(j)  (1280 + 64 * (j))
#define XB_XGEN(j)  (2304 + 64 * (j))
#define XB_TOP      3328
#define XB_TOPGEN   3392
#define XCD_BAR_WORDS 3456
#define XB_SPIN_CAP (1u << 18)

__device__ __forceinline__ unsigned xb_ld(unsigned* p)              { return __hip_atomic_load(p, __ATOMIC_RELAXED, __HIP_MEMORY_SCOPE_AGENT); }
__device__ __forceinline__ unsigned xb_add(unsigned* p, unsigned v) { return __hip_atomic_fetch_add(p, v, __ATOMIC_RELAXED, __HIP_MEMORY_SCOPE_AGENT); }
__device__ __forceinline__ unsigned xb_xcc_id() { return (unsigned)__builtin_amdgcn_s_getreg((3 << 11) | 20) & 0xFu; }
#define XB_SPIN(cond, bar) do { unsigned _sp = 0; while (cond) { __builtin_amdgcn_s_sleep(1); \
    if ((++_sp & 255u) == 0u) { if (xb_ld(&(bar)[XB_TMO])) break; if (_sp > XB_SPIN_CAP) { atomicAdd(&(bar)[XB_TMO], 1u); break; } } } } while (0)

struct XcdBarrier {
    unsigned* bar; unsigned x;
    volatile LAS unsigned* st;
};

__device__ __forceinline__ XcdBarrier xcd_barrier_post(unsigned* bar, volatile LAS unsigned* st) {
    XcdBarrier b; b.bar = bar; b.x = xb_xcc_id(); b.st = st;
    if (threadIdx.x == 0) (void)xb_add(&bar[XB_XCNT(b.x)], 1u);
    return b;
}
__device__ __forceinline__ void xcd_barrier_complete(unsigned* bar, unsigned x, unsigned& nloc, unsigned& nx) {
    const unsigned G = gridDim.x * gridDim.y * gridDim.z;
    unsigned sum, cnt, mine, sp = 0u;
    for (;;) {
        sum = 0u; cnt = 0u; mine = 0u;
#pragma unroll
        for (unsigned j = 0; j < 16; ++j) { const unsigned c = xb_ld(&bar[XB_XCNT(j)]); sum += c; cnt += (c > 0u) ? 1u : 0u; mine = (j == x) ? c : mine; }
        if (sum == G) break;
        __builtin_amdgcn_s_sleep(1);
        if ((++sp & 255u) == 0u) { if (xb_ld(&bar[XB_TMO])) break; if (sp > XB_SPIN_CAP) { atomicAdd(&bar[XB_TMO], 1u); break; } }
    }
    nloc = mine > 0u ? mine : 1u; nx = cnt > 0u ? cnt : 1u;
}

__device__ __forceinline__ void xcd_barrier(const XcdBarrier& b) {
    asm volatile("s_waitcnt vmcnt(0)" ::: "memory");
    __syncthreads();
    if (threadIdx.x == 0) {
        unsigned* bar = b.bar;
        __builtin_amdgcn_s_waitcnt(0);
        unsigned nloc = b.st[0], nx = b.st[1];
        if (nloc == 0u) { xcd_barrier_complete(bar, b.x, nloc, nx); b.st[0] = nloc; b.st[1] = nx; }
        const unsigned old = xb_add(&bar[XB_XSUB(b.x)], 1u);
        const unsigned gen = old / nloc;
        if (old + 1u == (gen + 1u) * nloc) {
            __builtin_amdgcn_fence(__ATOMIC_RELEASE, "agent");
            asm volatile("s_waitcnt vmcnt(0)" ::: "memory");
            const unsigned og = xb_add(&bar[XB_TOP], 1u);
            const unsigned tg = og / nx;
            if (og + 1u == (tg + 1u) * nx) xb_add(&bar[XB_TOPGEN], 1u);
            else XB_SPIN(xb_ld(&bar[XB_TOPGEN]) == tg, bar);
            __builtin_amdgcn_fence(__ATOMIC_ACQUIRE, "agent");
            xb_add(&bar[XB_XGEN(b.x)], 1u);
            asm volatile("s_waitcnt vmcnt(0)" ::: "memory");
        } else {
            XB_SPIN(xb_ld(&bar[XB_XGEN(b.x)]) == gen, bar);
            __builtin_amdgcn_fence(__ATOMIC_ACQUIRE, "agent");
            asm volatile("s_waitcnt vmcnt(0)" ::: "memory");
        }
    }
    __syncthreads();
}
typedef unsigned u32x4 __attribute__((ext_vector_type(4)));
__device__ __forceinline__ unsigned cvtpk2(float lo, float hi) { return pg8::cvtpk(lo, hi); }

constexpr int NWAVES = 8;
constexpr int D = 1024, LSEQ = 16384, NCTX = 256, MT = LSEQ + NCTX, DFF = 2816, NMOD = 9, MODW = NMOD * D;
constexpr int GRID_W = 64, NHEADS = 8, HD = 64, NAW = 512;
constexpr float RMS_EPS = 1e-6f, LOG2E = 1.4426950408889634f;
constexpr int N_PHASES = 22;

constexpr size_t MiB = 1u << 20;
constexpr size_t WS_CTL = 0, CTL_ZERO_BYTES = 1 * MiB;
constexpr size_t WS_MOD = 1 * MiB;
constexpr size_t WS_W13T = 2 * MiB, W13T_BYTES = (size_t)2 * DFF * D * 2;
constexpr size_t WS_W2T = 46 * MiB, W2T_BYTES = (size_t)D * DFF * 2;
constexpr size_t WS_WINT = 68 * MiB, WS_WOUTT = 72 * MiB, WS_CINT = 74 * MiB, WS_COUTT = 80 * MiB;
constexpr size_t WS_XRES = 82 * MiB;
constexpr size_t WS_ACT = 147 * MiB;
constexpr size_t WS_H = 180 * MiB;
constexpr size_t WS_Q = 180 * MiB, WS_K = 196 * MiB, WS_VT = 213 * MiB, WS_U = 230 * MiB;
constexpr size_t WS_BG = 180 * MiB, WS_Z = 212 * MiB;
constexpr size_t WS_END = 270 * MiB;
static_assert(WS_W13T + 4 * W13T_BYTES <= WS_W2T && WS_W2T + 4 * W2T_BYTES <= WS_WINT && WS_XRES + (size_t)MT * D * 4 <= WS_ACT && WS_ACT + (size_t)MT * D * 2 <= WS_H && WS_H + (size_t)MT * DFF * 2 <= WS_END, "d_ws map");
static_assert(WS_K + (size_t)MT * 512 * 2 <= WS_VT && WS_VT + (size_t)MT * 512 * 2 <= WS_U && WS_U + (size_t)LSEQ * 512 * 2 <= WS_END, "mixer overlay map");
constexpr int CW_BAR = 4096;

constexpr int RING_OFF = 0, RING_BYTES = 131072;
constexpr int LDSCTL_OFF = RING_BYTES, MISC_OFF = LDSCTL_OFF + 320;
constexpr int STAB_OFF = RING_BYTES + 1024;
constexpr int LDS_BYTES = 147456;
static_assert(STAB_OFF + 8192 <= LDS_BYTES, "LDS map");

struct Frame {
    LAS unsigned char* lds;
    volatile LAS unsigned* MISC;
    gu32* ctl;
    int tid, lane, wave, vcu, G;
    const float* in[18];
    float* out; unsigned char* ws;
};
__device__ __forceinline__ float wave_sum(float v) {
#pragma unroll
    for (int o = 1; o < 64; o <<= 1) v += __shfl_xor(v, o);
    return v;
}

__device__ __forceinline__ void p0_transpose_item(const float* W, int K, int ldn, bf16* WT, int k0, int n0, int drow0, LAS float* scr, int lane) {
#pragma unroll 8
    for (int i = 0; i < 32; ++i) { const int kk = 2 * i + (lane >> 5); scr[kk * 33 + (lane & 31)] = W[(size_t)(k0 + kk) * ldn + n0 + (lane & 31)]; }
    LDS_WAIT(); asm volatile("" ::: "memory");
    const int c = lane & 7;
#pragma unroll
    for (int j = 0; j < 4; ++j) { const int n = (lane >> 3) + 8 * j; const LAS float* s = scr + (8 * c) * 33 + n;
        v4u o; o.x = pk2(s[0 * 33], s[1 * 33]); o.y = pk2(s[2 * 33], s[3 * 33]); o.z = pk2(s[4 * 33], s[5 * 33]); o.w = pk2(s[6 * 33], s[7 * 33]);
        *(GAS v4u*)(WT + (size_t)(drow0 + n) * K + k0 + 8 * c) = o; }
    LDS_WAIT(); asm volatile("" ::: "memory");
}
__device__ __forceinline__ int map_swiglu(int n0) { const int half = n0 / DFF, hx = n0 % DFF; return 256 * (hx / 128) + 128 * half + (hx % 128); }
__device__ __forceinline__ int map_cin(int n0) { if (n0 < D) return n0; const int part = (n0 - D) / D, ch = (n0 - D) % D; return D + 256 * (ch / 128) + 128 * part + (ch % 128); }

__device__ __forceinline__ void p0_prologue(Frame& F) {
    LAS float* scr = (LAS float*)(F.lds + RING_OFF + F.wave * 16384);
    LAS float* stab = (LAS float*)(F.lds + STAB_OFF);
    const int gw = F.vcu * NWAVES + F.wave, NGW = F.G * NWAVES, lane = F.lane;
    for (int k = F.tid; k < D; k += NWAVES * 64) { const float a = F.in[1][k], b = F.in[3][k]; stab[k] = a / (1.0f + expf(-a)); stab[D + k] = b / (1.0f + expf(-b)); }
    __syncthreads();
    {
        float* mv = (float*)(F.ws + WS_MOD);
        constexpr int NCH = MODW / 16;
        for (int it = gw; it < 2 * NCH; it += NGW) {
            const int layer = it / NCH, col0 = (it % NCH) * 16, cq = lane & 3, kr = lane >> 2;
            const GAS float* W = (const GAS float*)(F.in[4] + (size_t)layer * D * MODW + col0 + 4 * cq);
            f32x4 al = {0.f, 0.f, 0.f, 0.f}, ac = {0.f, 0.f, 0.f, 0.f};
#pragma unroll 8
            for (int i = 0; i < 64; ++i) { const int k = kr + 16 * i; const f32x4 w = *(const GAS f32x4*)(W + (size_t)k * MODW); al += w * stab[k]; ac += w * stab[D + k]; }
#pragma unroll
            for (int e = 0; e < 4; ++e) {
#pragma unroll
                for (int o = 4; o < 64; o <<= 1) { al[e] += __shfl_xor(al[e], o); ac[e] += __shfl_xor(ac[e], o); } }
            if (lane < 4) {
                const f32x4 b = *(const f32x4*)(F.in[5] + (size_t)layer * MODW + col0 + 4 * cq);
                if (layer == 0) { *(f32x4*)(mv + col0 + 4 * cq) = al + b; *(f32x4*)(mv + MODW + col0 + 4 * cq) = ac + b; }
                else *(f32x4*)(mv + 2 * MODW + col0 + 4 * cq) = al + b;
            }
        }
    }
    {
        bf16* WINt = (bf16*)(F.ws + WS_WINT);
        for (int it = gw; it < 4 * 64; it += NGW) {
            const int g = it >> 6, k0 = (it & 63) * 16;
#pragma unroll
            for (int i = 0; i < 32; ++i) { const int e = i * 64 + lane, kk = e >> 7, j = e & 127; scr[e] = F.in[9][(size_t)(k0 + kk) * 2048 + 1536 + g * 128 + j]; }
            LDS_WAIT(); asm volatile("" ::: "memory");
            float a0[16], a1[16];
#pragma unroll
            for (int kk = 0; kk < 16; ++kk) { a0[kk] = 0.f; a1[kk] = 0.f; }
            const GAS float* P = (const GAS float*)(F.in[12] + (size_t)g * 128 * 128);
            for (int j = 0; j < 128; ++j) {
                const float p0 = P[j * 128 + lane], p1 = P[j * 128 + 64 + lane];
#pragma unroll
                for (int kk = 0; kk < 16; ++kk) { const float a = scr[kk * 128 + j]; a0[kk] += a * p0; a1[kk] += a * p1; }
            }
            const float s0 = F.in[13][g * 128 + lane], s1 = F.in[13][g * 128 + 64 + lane];
            v4u o0, o1, o2, o3;
            o0.x = pk2(a0[0] * s0, a0[1] * s0); o0.y = pk2(a0[2] * s0, a0[3] * s0); o0.z = pk2(a0[4] * s0, a0[5] * s0); o0.w = pk2(a0[6] * s0, a0[7] * s0);
            o1.x = pk2(a0[8] * s0, a0[9] * s0); o1.y = pk2(a0[10] * s0, a0[11] * s0); o1.z = pk2(a0[12] * s0, a0[13] * s0); o1.w = pk2(a0[14] * s0, a0[15] * s0);
            o2.x = pk2(a1[0] * s1, a1[1] * s1); o2.y = pk2(a1[2] * s1, a1[3] * s1); o2.z = pk2(a1[4] * s1, a1[5] * s1); o2.w = pk2(a1[6] * s1, a1[7] * s1);
            o3.x = pk2(a1[8] * s1, a1[9] * s1); o3.y = pk2(a1[10] * s1, a1[11] * s1); o3.z = pk2(a1[12] * s1, a1[13] * s1); o3.w = pk2(a1[14] * s1, a1[15] * s1);
            GAS v4u* d0 = (GAS v4u*)(WINt + (size_t)(1536 + g * 128 + lane) * D + k0);
            GAS v4u* d1 = (GAS v4u*)(WINt + (size_t)(1536 + g * 128 + 64 + lane) * D + k0);
            d0[0] = o0; d0[1] = o1; d1[0] = o2; d1[1] = o3;
            LDS_WAIT(); asm volatile("" ::: "memory");
        }
    }
    {
        constexpr int I_13 = (D / 64) * (2 * DFF / 32), I_2 = (DFF / 64) * (D / 32), I_IN = (D / 64) * (1536 / 32), I_SQ = (D / 64) * (D / 32), I_CI = (D / 64) * (3 * D / 32);
        constexpr int NITEMS = 4 * I_13 + 4 * I_2 + I_IN + I_SQ + I_CI + I_SQ;
        for (int it = gw; it < NITEMS; it += NGW) {
            int r = it;
            if (r < 4 * I_13) { const int mi = r / I_13, q = r % I_13, nblk = 2 * DFF / 32, kb = q / nblk, nb = q % nblk;
                p0_transpose_item(F.in[7] + (size_t)mi * D * 2 * DFF, D, 2 * DFF, (bf16*)(F.ws + WS_W13T + mi * W13T_BYTES), 64 * kb, 32 * nb, map_swiglu(32 * nb), scr, lane); continue; } r -= 4 * I_13;
            if (r < 4 * I_2) { const int mi = r / I_2, q = r % I_2, nblk = D / 32, kb = q / nblk, nb = q % nblk;
                p0_transpose_item(F.in[8] + (size_t)mi * DFF * D, DFF, D, (bf16*)(F.ws + WS_W2T + mi * W2T_BYTES), 64 * kb, 32 * nb, 32 * nb, scr, lane); continue; } r -= 4 * I_2;
            if (r < I_IN) { const int nblk = 1536 / 32, kb = r / nblk, nb = r % nblk;
                p0_transpose_item(F.in[9], D, 2048, (bf16*)(F.ws + WS_WINT), 64 * kb, 32 * nb, 32 * nb, scr, lane); continue; } r -= I_IN;
            if (r < I_SQ) { const int nblk = D / 32, kb = r / nblk, nb = r % nblk;
                p0_transpose_item(F.in[10], D, D, (bf16*)(F.ws + WS_WOUTT), 64 * kb, 32 * nb, 32 * nb, scr, lane); continue; } r -= I_SQ;
            if (r < I_CI) { const int nblk = 3 * D / 32, kb = r / nblk, nb = r % nblk;
                p0_transpose_item(F.in[14], D, 3 * D, (bf16*)(F.ws + WS_CINT), 64 * kb, 32 * nb, map_cin(32 * nb), scr, lane); continue; } r -= I_CI;
            { const int nblk = D / 32, kb = r / nblk, nb = r % nblk;
                p0_transpose_item(F.in[16], D, D, (bf16*)(F.ws + WS_COUTT), 64 * kb, 32 * nb, 32 * nb, scr, lane); }
        }
    }
}

__device__ __forceinline__ void norm_rows_bf16(Frame& F, const float* src, bf16* dst, int nrows, const float* g, const float* shift, const float* scale) {
    const int gw = F.vcu * NWAVES + F.wave, NGW = F.G * NWAVES, lane = F.lane;
    f32x4 A[4], B[4];
#pragma unroll
    for (int j = 0; j < 4; ++j) { const int c = 4 * lane + 256 * j; const f32x4 gv = *(const f32x4*)(g + c), sc = *(const f32x4*)(scale + c); A[j] = gv * (sc + 1.0f); B[j] = *(const f32x4*)(shift + c); }
    for (int m = gw; m < nrows; m += NGW) {
        const GAS f32x4* xr = (const GAS f32x4*)(src + (size_t)m * D) + lane;
        f32x4 v[4]; float s2 = 0.f;
#pragma unroll
        for (int j = 0; j < 4; ++j) { v[j] = xr[64 * j]; s2 += (v[j].x * v[j].x + v[j].y * v[j].y) + (v[j].z * v[j].z + v[j].w * v[j].w); }
        const float rstd = 1.0f / sqrtf(wave_sum(s2) * (1.0f / D) + RMS_EPS);
        GAS unsigned long long* o8 = (GAS unsigned long long*)(dst + (size_t)m * D) + lane;
#pragma unroll
        for (int j = 0; j < 4; ++j) { const f32x4 y = v[j] * rstd * A[j] + B[j]; o8[64 * j] = (unsigned long long)pk2(y.x, y.y) | ((unsigned long long)pk2(y.z, y.w) << 32); }
    }
}
__device__ __forceinline__ void norm_rows_final(Frame& F, const float* src, float* dst, int nrows, const float* g) {
    const int gw = F.vcu * NWAVES + F.wave, NGW = F.G * NWAVES, lane = F.lane;
    f32x4 A[4];
#pragma unroll
    for (int j = 0; j < 4; ++j) A[j] = *(const f32x4*)(g + 4 * lane + 256 * j);
    for (int m = gw; m < nrows; m += NGW) {
        const GAS f32x4* xr = (const GAS f32x4*)(src + (size_t)m * D) + lane;
        f32x4 v[4]; float s2 = 0.f;
#pragma unroll
        for (int j = 0; j < 4; ++j) { v[j] = xr[64 * j]; s2 += (v[j].x * v[j].x + v[j].y * v[j].y) + (v[j].z * v[j].z + v[j].w * v[j].w); }
        const float rstd = 1.0f / sqrtf(wave_sum(s2) * (1.0f / D) + RMS_EPS);
        GAS f32x4* o = (GAS f32x4*)(dst + (size_t)m * D) + lane;
#pragma unroll
        for (int j = 0; j < 4; ++j) o[64 * j] = v[j] * rstd * A[j];
    }
}

typedef float f32x16 __attribute__((ext_vector_type(16)));
typedef unsigned u32x2 __attribute__((ext_vector_type(2)));
__device__ __forceinline__ int crow(int r, int hi) { return (r & 3) + 8 * (r >> 2) + 4 * hi; }
__device__ __forceinline__ float bf_lo(unsigned w) { return __uint_as_float(w << 16); }
__device__ __forceinline__ float bf_hi(unsigned w) { return __uint_as_float(w & 0xffff0000u); }

__device__ __forceinline__ void att_task(const bf16* Qb, const bf16* Kb, const bf16* Vt, bf16* Ob, const LAS float* bias, int h, int r, int ch, int lane) {
    const int q = lane & 31, hi = lane >> 5, qc = 32 * ch + q, tq = GRID_W * r + qc;
    int rs = r - 4; rs = rs < 0 ? 0 : (rs > 248 ? 248 : rs);
    int cst = qc - 8; cst = cst < 0 ? 0 : (cst > 48 ? 48 : cst);
    bf16x8 qf[4];
#pragma unroll
    for (int d0 = 0; d0 < 4; ++d0) qf[d0] = *(const GAS bf16x8*)(Qb + (size_t)tq * NAW + h * HD + d0 * 16 + 8 * hi);
    float mrun = -1e30f, lsum = 0.f;
    f32x16 o0, o1;
#pragma unroll
    for (int i = 0; i < 16; ++i) { o0[i] = 0.f; o1[i] = 0.f; }
    const LAS float* bh = bias + h * 465;
    const GAS bf16* Vh = (const GAS bf16*)(Vt + (size_t)(h * HD + q) * MT);
    for (int b = 0; b < 20; ++b) {
        const bool isw = b >= 8;
        int ktok, vb0, vb1, kr0 = 0, c16 = 0;
        if (!isw) { const int tok0 = LSEQ + 32 * b; ktok = tok0 + q; vb0 = tok0; vb1 = tok0 + 16; }
        else { const int wb = b - 8, rp = wb / 3, cc = wb - 3 * rp; kr0 = rs + 2 * rp; c16 = 16 * ch + 16 * cc; ktok = (kr0 + (q >> 4)) * GRID_W + c16 + (q & 15); vb0 = kr0 * GRID_W + c16; vb1 = vb0 + GRID_W; }
        bf16x8 kf[4];
#pragma unroll
        for (int d0 = 0; d0 < 4; ++d0) kf[d0] = *(const GAS bf16x8*)(Kb + (size_t)ktok * NAW + h * HD + d0 * 16 + 8 * hi);
        u32x2 va[2][2][2];
#pragma unroll
        for (int dh = 0; dh < 2; ++dh)
#pragma unroll
            for (int s = 0; s < 2; ++s) { const GAS bf16* p = Vh + (size_t)dh * 32 * MT + (s ? vb1 : vb0) + 4 * hi;
                va[dh][s][0] = *(const GAS u32x2*)p; va[dh][s][1] = *(const GAS u32x2*)(p + 8); }
        f32x16 S;
#pragma unroll
        for (int i = 0; i < 16; ++i) S[i] = 0.f;
#pragma unroll
        for (int d0 = 0; d0 < 4; ++d0) S = __builtin_amdgcn_mfma_f32_32x32x16_bf16(kf[d0], qf[d0], S, 0, 0, 0);
        if (isw) {
#pragma unroll
            for (int i = 0; i < 16; ++i) {
                const int kj = crow(i, hi), krow = kr0 + (kj >> 4), kc = c16 + (kj & 15);
                int ci = kc - qc + 15; ci = ci < 0 ? 0 : (ci > 30 ? 30 : ci);
                const float bv = bh[(krow - r + 7) * 31 + ci];
                S[i] = (kc >= cst && kc < cst + 16) ? S[i] + bv : -INFINITY;
            }
        }
        float bm = S[0];
#pragma unroll
        for (int i = 1; i < 16; ++i) bm = fmaxf(bm, S[i]);
        bm = fmaxf(bm, __shfl_xor(bm, 32));
        const float mn = fmaxf(mrun, bm), alpha = __builtin_amdgcn_exp2f(mrun - mn);
        mrun = mn;
        float ps = 0.f;
#pragma unroll
        for (int i = 0; i < 16; ++i) { S[i] = __builtin_amdgcn_exp2f(S[i] - mn); ps += S[i]; }
        lsum = lsum * alpha + ps;
#pragma unroll
        for (int i = 0; i < 16; ++i) { o0[i] *= alpha; o1[i] *= alpha; }
        u32x4 pw0, pw1;
        pw0.x = cvtpk2(S[0], S[1]); pw0.y = cvtpk2(S[2], S[3]); pw0.z = cvtpk2(S[4], S[5]); pw0.w = cvtpk2(S[6], S[7]);
        pw1.x = cvtpk2(S[8], S[9]); pw1.y = cvtpk2(S[10], S[11]); pw1.z = cvtpk2(S[12], S[13]); pw1.w = cvtpk2(S[14], S[15]);
        const bf16x8 pb0 = __builtin_bit_cast(bf16x8, pw0), pb1 = __builtin_bit_cast(bf16x8, pw1);
#define VFRAG(dh, s) __builtin_bit_cast(bf16x8, (u32x4){va[dh][s][0].x, va[dh][s][0].y, va[dh][s][1].x, va[dh][s][1].y})
        o0 = __builtin_amdgcn_mfma_f32_32x32x16_bf16(VFRAG(0, 0), pb0, o0, 0, 0, 0);
        o0 = __builtin_amdgcn_mfma_f32_32x32x16_bf16(VFRAG(0, 1), pb1, o0, 0, 0, 0);
        o1 = __builtin_amdgcn_mfma_f32_32x32x16_bf16(VFRAG(1, 0), pb0, o1, 0, 0, 0);
        o1 = __builtin_amdgcn_mfma_f32_32x32x16_bf16(VFRAG(1, 1), pb1, o1, 0, 0, 0);
#undef VFRAG
    }
    lsum += __shfl_xor(lsum, 32);
    const float inv = 1.0f / lsum;
    GAS bf16* orow = (GAS bf16*)(Ob + (size_t)tq * D + h * HD);
#pragma unroll
    for (int g4 = 0; g4 < 4; ++g4) {
        u32x2 w0, w1;
        w0.x = cvtpk2(o0[4 * g4] * inv, o0[4 * g4 + 1] * inv); w0.y = cvtpk2(o0[4 * g4 + 2] * inv, o0[4 * g4 + 3] * inv);
        w1.x = cvtpk2(o1[4 * g4] * inv, o1[4 * g4 + 1] * inv); w1.y = cvtpk2(o1[4 * g4 + 2] * inv, o1[4 * g4 + 3] * inv);
        *(GAS u32x2*)(orow + 8 * g4 + 4 * hi) = w0;
        *(GAS u32x2*)(orow + 32 + 8 * g4 + 4 * hi) = w1;
    }
}
__device__ __forceinline__ void pool_task(const bf16* Ub, bf16* Ob, int t0, int lane) {
    const int g = lane >> 4, hw = 1 << g;
    u32x4 rw[23];
#pragma unroll
    for (int j = 0; j < 23; ++j) { const int t = t0 - 8 + j; rw[j] = (t >= 0 && t < LSEQ) ? *(const GAS u32x4*)(Ub + (size_t)t * NAW + 8 * lane) : (u32x4){0u, 0u, 0u, 0u}; }
#pragma unroll
    for (int i = 0; i < 8; ++i) {
        const int t = t0 + i, ci = i + 8;
        int lo = t - hw; lo = lo < 0 ? 0 : lo; int hi_ = t + hw; hi_ = hi_ > LSEQ ? LSEQ : hi_;
        const float rc = 1.0f / (float)(hi_ - lo);
        u32x4 ow;
#pragma unroll
        for (int d = 0; d < 4; ++d) {
            float sl = 0.f, sh = 0.f, r1l, r1h, r2l, r2h, r4l, r4h;
#define ADDROW(j) do { sl += bf_lo(rw[j][d]); sh += bf_hi(rw[j][d]); } while (0)
            ADDROW(ci - 1); ADDROW(ci); r1l = sl; r1h = sh;
            ADDROW(ci - 2); ADDROW(ci + 1); r2l = sl; r2h = sh;
            ADDROW(ci - 4); ADDROW(ci - 3); ADDROW(ci + 2); ADDROW(ci + 3); r4l = sl; r4h = sh;
            ADDROW(ci - 8); ADDROW(ci - 7); ADDROW(ci - 6); ADDROW(ci - 5); ADDROW(ci + 4); ADDROW(ci + 5); ADDROW(ci + 6); ADDROW(ci + 7);
#undef ADDROW
            const float vl = g == 0 ? r1l : (g == 1 ? r2l : (g == 2 ? r4l : sl)), vh = g == 0 ? r1h : (g == 1 ? r2h : (g == 2 ? r4h : sh));
            ow[d] = cvtpk2(vl * rc - bf_lo(rw[ci][d]), vh * rc - bf_hi(rw[ci][d]));
        }
        *(GAS u32x4*)(Ob + (size_t)t * D + NAW + 8 * lane) = ow;
    }
}
__device__ __forceinline__ void att_phase(Frame& F) {
    LAS float* bias = (LAS float*)(F.lds + RING_OFF);
    for (int i = F.tid; i < NHEADS * 465; i += NWAVES * 64) bias[i] = F.in[11][i] * LOG2E;
    __syncthreads();
    const int gw = F.vcu * NWAVES + F.wave, NGW = F.G * NWAVES;
    const bf16* Qb = (const bf16*)(F.ws + WS_Q); const bf16* Kb = (const bf16*)(F.ws + WS_K); const bf16* Vt = (const bf16*)(F.ws + WS_VT); const bf16* Ub = (const bf16*)(F.ws + WS_U);
    bf16* Ob = (bf16*)(F.ws + WS_ACT);
    for (int T = gw; T < 4096; T += NGW) {
        const int blk = T >> 3, w8 = T & 7, x = (blk & 255) >> 5, bl = (blk & 31) + 32 * (blk >> 8);
        const int h = bl >> 3, rg = bl & 7, r = 32 * x + 4 * rg + (w8 >> 1), ch = w8 & 1;
        att_task(Qb, Kb, Vt, Ob, bias, h, r, ch, F.lane);
    }
    for (int T = gw; T < LSEQ / 8; T += NGW) pool_task(Ub, Ob, 8 * T, F.lane);
    __syncthreads();
}
__device__ __forceinline__ void conv_phase(Frame& F) {
    const int gw = F.vcu * NWAVES + F.wave, NGW = F.G * NWAVES, lane = F.lane;
    const bf16* BG = (const bf16*)(F.ws + WS_BG); const bf16* Z = (const bf16*)(F.ws + WS_Z); bf16* P = (bf16*)(F.ws + WS_ACT);
    const float* cw = F.in[15];
    for (int T = gw; T < LSEQ / 8; T += NGW) {
        const int t0 = 8 * T;
#pragma unroll
        for (int hf = 0; hf < 2; ++hf) {
            const int c0 = 512 * hf + 8 * lane;
            float w[3][8];
#pragma unroll
            for (int k = 0; k < 3; ++k) { const f32x4 a = *(const f32x4*)(cw + k * D + c0), b = *(const f32x4*)(cw + k * D + c0 + 4);
                w[k][0] = a.x; w[k][1] = a.y; w[k][2] = a.z; w[k][3] = a.w; w[k][4] = b.x; w[k][5] = b.y; w[k][6] = b.z; w[k][7] = b.w; }
            u32x4 zr[10];
#pragma unroll
            for (int j = 0; j < 10; ++j) { const int t = t0 - 1 + j; zr[j] = (t >= 0 && t < LSEQ) ? *(const GAS u32x4*)(Z + (size_t)t * D + c0) : (u32x4){0u, 0u, 0u, 0u}; }
#pragma unroll
            for (int i = 0; i < 8; ++i) {
                const u32x4 bg = *(const GAS u32x4*)(BG + (size_t)(t0 + i) * D + c0);
                u32x4 ow;
#pragma unroll
                for (int d = 0; d < 4; ++d) {
                    const float yl = w[0][2 * d] * bf_lo(zr[i][d]) + w[1][2 * d] * bf_lo(zr[i + 1][d]) + w[2][2 * d] * bf_lo(zr[i + 2][d]);
                    const float yh = w[0][2 * d + 1] * bf_hi(zr[i][d]) + w[1][2 * d + 1] * bf_hi(zr[i + 1][d]) + w[2][2 * d + 1] * bf_hi(zr[i + 2][d]);
                    ow[d] = cvtpk2(bf_lo(bg[d]) * yl, bf_hi(bg[d]) * yh);
                }
                *(GAS u32x4*)(P + (size_t)(t0 + i) * D + c0) = ow;
            }
        }
    }
}

struct Args { const float* in[18]; float* out; unsigned char* ws; int ph_lo, ph_hi; };
static_assert(sizeof(Args) == 18 * 8 + 8 + 8 + 8, "Args has no padding");

__device__ __forceinline__ void ffn_up(Frame& F, int widx, int M) {
    pg8::Gemm g{(const bf16*)(F.ws + WS_ACT), (const bf16*)(F.ws + WS_W13T + (size_t)widx * W13T_BYTES), M, 2 * DFF, D};
    pg8::StaticOrder S; S.init(M, 2 * DFF, F.G, (int)blockIdx.x);
    pg8::EpiSwiGLU E{(bf16*)(F.ws + WS_H), DFF};
    pg8::gemm_phase<pg8::EpiSwiGLU, pg8::StaticOrder, true, true>(F.lds + RING_OFF, g, S, E);
}
__device__ __forceinline__ void ffn_down(Frame& F, int widx, int M, const float* base_l, const float* base_c, const float* gate_l, const float* gate_c) {
    pg8::Gemm g{(const bf16*)(F.ws + WS_H), (const bf16*)(F.ws + WS_W2T + (size_t)widx * W2T_BYTES), M, D, DFF};
    pg8::StaticOrder S; S.init(M, D, F.G, (int)blockIdx.x);
    pg8::EpiResid E{base_l, base_c, (float*)(F.ws + WS_XRES), gate_l, gate_c, 0.5f, LSEQ, D};
    pg8::gemm_phase<pg8::EpiResid, pg8::StaticOrder, true, true>(F.lds + RING_OFF, g, S, E);
}
__device__ __forceinline__ void proj_out(Frame& F, size_t wt_off, const float* gate) {
    float* xres = (float*)(F.ws + WS_XRES);
    pg8::Gemm g{(const bf16*)(F.ws + WS_ACT), (const bf16*)(F.ws + wt_off), LSEQ, D, D};
    pg8::StaticOrder S; S.init(LSEQ, D, F.G, (int)blockIdx.x);
    pg8::EpiResid E{xres, xres, xres, gate, gate, 1.0f, LSEQ, D};
    pg8::gemm_phase<pg8::EpiResid, pg8::StaticOrder, true, true>(F.lds + RING_OFF, g, S, E);
}

__global__ void __launch_bounds__(NWAVES * 64, 2) mk_fwd(Args args) {
    extern __shared__ __attribute__((aligned(16))) unsigned char lds[];
    Frame F;
    F.lds = (LAS unsigned char*)lds;
    F.MISC = (volatile LAS unsigned*)(F.lds + MISC_OFF);
    F.tid = threadIdx.x; F.lane = F.tid & 63; F.wave = __builtin_amdgcn_readfirstlane(F.tid >> 6);
    F.G = gridDim.x; { const int bx = blockIdx.x; F.vcu = (F.G % 8 == 0) ? (bx % 8) * (F.G / 8) + bx / 8 : bx; }
    F.ws = args.ws; F.out = args.out; F.ctl = (gu32*)(args.ws + WS_CTL);
#pragma unroll
    for (int i = 0; i < 18; ++i) F.in[i] = args.in[i];
    for (int u = F.tid; u < (LDS_BYTES - LDSCTL_OFF) / 4; u += NWAVES * 64) ((LAS unsigned*)(F.lds + LDSCTL_OFF))[u] = 0u;
    __syncthreads();
    const int lo = args.ph_lo, hi = args.ph_hi;
    const bool multi = (hi - lo) > 1;
    XcdBarrier bar; bar.bar = (unsigned*)(F.ctl + CW_BAR); bar.x = 0; bar.st = nullptr;
    if (multi) bar = xcd_barrier_post((unsigned*)(F.ctl + CW_BAR), F.MISC + 8);
#define IN(k) (lo <= (k) && (k) < hi)
#define SEAM(k) do { if (IN(k) && IN((k) + 1)) xcd_barrier(bar); } while (0)
    const float* mv = (const float*)(F.ws + WS_MOD);
    const float* ml0 = mv; const float* mc0 = mv + MODW; const float* ml1 = mv + 2 * MODW;
    float* xres = (float*)(F.ws + WS_XRES);
    bf16* act = (bf16*)(F.ws + WS_ACT);
    const float* ng = F.in[6];

    if (IN(0)) { p0_prologue(F); } SEAM(0);
    if (IN(1)) { norm_rows_bf16(F, F.in[0], act, LSEQ, ng + 0 * D, ml0 + 0 * D, ml0 + 1 * D);
                 norm_rows_bf16(F, F.in[2], act + (size_t)LSEQ * D, NCTX, ng + 0 * D, mc0 + 0 * D, mc0 + 1 * D); } SEAM(1);
    if (IN(2)) { ffn_up(F, 0, MT); } SEAM(2);
    if (IN(3)) { ffn_down(F, 0, MT, F.in[0], F.in[2], ml0 + 2 * D, mc0 + 2 * D); } SEAM(3);
    if (IN(4)) { norm_rows_bf16(F, xres, act, LSEQ, ng + 1 * D, ml0 + 3 * D, ml0 + 4 * D);
                 norm_rows_bf16(F, xres + (size_t)LSEQ * D, act + (size_t)LSEQ * D, NCTX, ng + 1 * D, mc0 + 3 * D, mc0 + 4 * D); } SEAM(4);
    if (IN(5)) {
        pg8::Gemm g{(const bf16*)act, (const bf16*)(F.ws + WS_WINT), LSEQ, 2048, D};
        pg8::WinOrder S; S.init(LSEQ, 2048, F.G, (int)blockIdx.x);
        pg8::EpiWin E{F.ws + WS_Q, (bf16*)(F.ws + WS_VT), 0.125f * LOG2E, MT, (unsigned)(WS_K - WS_Q), (unsigned)(WS_U - WS_Q)};
        pg8::gemm_phase<pg8::EpiWin, pg8::WinOrder, true, true>(F.lds + RING_OFF, g, S, E);
    } SEAM(5);
    if (IN(6)) { att_phase(F); } SEAM(6);
    if (IN(7)) { proj_out(F, WS_WOUTT, ml0 + 5 * D); } SEAM(7);
    if (IN(8)) { norm_rows_bf16(F, xres, act, LSEQ, ng + 2 * D, ml0 + 6 * D, ml0 + 7 * D); } SEAM(8);
    if (IN(9)) { ffn_up(F, 1, LSEQ); } SEAM(9);
    if (IN(10)) { ffn_down(F, 1, LSEQ, xres, xres, ml0 + 8 * D, ml0 + 8 * D); } SEAM(10);
    if (IN(11)) { norm_rows_bf16(F, xres, act, LSEQ, ng + 3 * D, ml1 + 0 * D, ml1 + 1 * D); } SEAM(11);
    if (IN(12)) { ffn_up(F, 2, LSEQ); } SEAM(12);
    if (IN(13)) { ffn_down(F, 2, LSEQ, xres, xres, ml1 + 2 * D, ml1 + 2 * D); } SEAM(13);
    if (IN(14)) { norm_rows_bf16(F, xres, act, LSEQ, ng + 4 * D, ml1 + 3 * D, ml1 + 4 * D); } SEAM(14);
    if (IN(15)) {
        pg8::Gemm g{(const bf16*)act, (const bf16*)(F.ws + WS_CINT), LSEQ, 3 * D, D};
        pg8::StaticOrder S; S.init(LSEQ, 3 * D, F.G, (int)blockIdx.x);
        pg8::EpiCin E{(bf16*)(F.ws + WS_BG), (bf16*)(F.ws + WS_Z)};
        pg8::gemm_phase<pg8::EpiCin, pg8::StaticOrder, true, true>(F.lds + RING_OFF, g, S, E);
    } SEAM(15);
    if (IN(16)) { conv_phase(F); } SEAM(16);
    if (IN(17)) { proj_out(F, WS_COUTT, ml1 + 5 * D); } SEAM(17);
    if (IN(18)) { norm_rows_bf16(F, xres, act, LSEQ, ng + 5 * D, ml1 + 6 * D, ml1 + 7 * D); } SEAM(18);
    if (IN(19)) { ffn_up(F, 3, LSEQ); } SEAM(19);
    if (IN(20)) { ffn_down(F, 3, LSEQ, xres, xres, ml1 + 8 * D, ml1 + 8 * D); } SEAM(20);
    if (IN(21)) { norm_rows_final(F, xres, F.out, LSEQ, F.in[17]); }
#undef IN
#undef SEAM
}

#ifndef MK_PER_PHASE
#define MK_PER_PHASE 0
#endif
extern "C" void kernel_launch(void* const* d_in, const int* in_sizes, int n_in, void* d_out, int out_size, void* d_ws, size_t ws_size, hipStream_t stream) {
    static int grid = 0;
    if (grid == 0) {
        if (n_in != 18 || in_sizes[0] != LSEQ * D || out_size != LSEQ * D || ws_size < WS_END) { fprintf(stderr, "kernel_launch: shape/workspace mismatch (n_in %d, in0 %d, out %d, ws %zu)\n", n_in, n_in > 0 ? in_sizes[0] : -1, out_size, ws_size); grid = -1; return; }
        int dev = 0, cus = 0;
        if (hipGetDevice(&dev) != hipSuccess || hipDeviceGetAttribute(&cus, hipDeviceAttributeMultiprocessorCount, dev) != hipSuccess) { grid = -1; return; }
        if (hipFuncSetAttribute((const void*)mk_fwd, hipFuncAttributeMaxDynamicSharedMemorySize, LDS_BYTES) != hipSuccess) { fprintf(stderr, "kernel_launch: hipFuncSetAttribute failed\n"); grid = -1; return; }
        (void)hipGetLastError();
        grid = cus;
    }
    if (grid < 0) return;
    if (hipMemsetAsync((char*)d_ws + WS_CTL, 0, CTL_ZERO_BYTES, stream) != hipSuccess) return;
    Args a{};
    for (int i = 0; i < 18; ++i) a.in[i] = (const float*)d_in[i];
    a.out = (float*)d_out; a.ws = (unsigned char*)d_ws;
#if MK_PER_PHASE
    for (int p = 0; p < N_PHASES; ++p) { a.ph_lo = p; a.ph_hi = p + 1; hipLaunchKernelGGL(mk_fwd, dim3(grid), dim3(NWAVES * 64), LDS_BYTES, stream, a); }
#else
    a.ph_lo = 0; a.ph_hi = N_PHASES; hipLaunchKernelGGL(mk_fwd, dim3(grid), dim3(NWAVES * 64), LDS_BYTES, stream, a);
#endif
}
```

```cpp
#include <hip/hip_runtime.h>
#include <cstdio>
#include <cstdint>
#include <cmath>
namespace pg8 {
#define PG8_LAS __attribute__((address_space(3)))
typedef unsigned short bf16_t;
typedef short bf16x8 __attribute__((ext_vector_type(8)));
typedef float f32x4 __attribute__((ext_vector_type(4)));
typedef unsigned u32x4 __attribute__((ext_vector_type(4)));
constexpr int BM = 256, BK = 64, HALF = 128, HTB = HALF * BK * 2  , STAGE_BYTES = 8 * HTB, NXCD = 8, WGM = 8;

__host__ __device__ __forceinline__ int lds_byte(int r, int c) { const int st = (r >> 4) * 2 + (c >> 5), rr = r & 15, cc = c & 31, ob = rr * 64 + cc * 2; return st * 1024 + (ob ^ (((ob >> 9) & 1) << 5)); }
__host__ __device__ __forceinline__ void stage_rc(int b, int& R, int& C) { const int st = b / 1024, sb = b % 1024, swz = sb ^ (((sb >> 9) & 1) << 5); R = (st >> 1) * 16 + swz / 64; C = (st & 1) * 32 + (swz % 64) / 2; }
__host__ __device__ __forceinline__ int perm32(int rho) { const int n = rho >> 4, i = rho & 15; return 8 * (i >> 2) + 4 * n + (i & 3); }

struct Unit { int pm, pn; };
struct Gemm { const bf16_t* A; const bf16_t* Bt; int M, N, K; };

struct StaticOrder {
    int nM, nN, nwg, G, c;
    __host__ __device__ void init(int M, int N, int G_, int c_) { nM = M / BM; nN = N / BM; nwg = nM * nN; G = G_; c = c_; }
    __host__ __device__ bool next(int i, Unit& u) const {
        const long L = (long)i * G + c; if (L >= nwg) return false;
        int wgid = (int)L; { const int q = nwg / NXCD, r = nwg % NXCD, xcd = wgid % NXCD, off = wgid / NXCD; wgid = (xcd < r ? xcd * (q + 1) : r * (q + 1) + (xcd - r) * q) + off; }
        const int nig = WGM * nN, gid = wgid / nig, fm = gid * WGM, gsz = (nM - fm) < WGM ? (nM - fm) : WGM;
        u.pm = fm + ((wgid % nig) % gsz); u.pn = (wgid % nig) / gsz; return true;
    }
    __device__ __forceinline__ void a_ready(const Unit&) const {}
    __device__ __forceinline__ void done(const Unit&) const {}
};

typedef float f32x2 __attribute__((ext_vector_type(2)));
typedef __bf16 bf16x2_t __attribute__((ext_vector_type(2)));
__device__ __forceinline__ unsigned cvtpk(float lo, float hi) { f32x2 v = {lo, hi}; bf16x2_t b = __builtin_convertvector(v, bf16x2_t); return __builtin_bit_cast(unsigned, b); }
__device__ __forceinline__ float silu_f(float a) { return a * __builtin_amdgcn_rcpf(1.0f + __builtin_amdgcn_exp2f(-1.4426950408889634f * a)); }

__device__ __forceinline__ void store_tile_bf16(const f32x4 (&acc)[2][2][4][2], bf16_t* O, int ldc, int row0, int col0, float sc) {
#pragma unroll
    for (int ai = 0; ai < 2; ++ai)
#pragma unroll
        for (int m = 0; m < 4; ++m) { bf16_t* rowp = O + (size_t)(row0 + ai * HALF + m * 16) * ldc + col0;
#pragma unroll
            for (int bj = 0; bj < 2; ++bj) { const f32x4 v0 = acc[ai][bj][m][0] * sc, v1 = acc[ai][bj][m][1] * sc;
                u32x4 w; w.x = cvtpk(v0[0], v0[1]); w.y = cvtpk(v0[2], v0[3]); w.z = cvtpk(v1[0], v1[1]); w.w = cvtpk(v1[2], v1[3]);
                *(u32x4*)(rowp + bj * HALF) = w; } }
}
template <bool SILU> __device__ __forceinline__ void store_tile_prod(const f32x4 (&acc)[2][2][4][2], bf16_t* O, int ldc, int row0, int col0) {
#pragma unroll
    for (int ai = 0; ai < 2; ++ai)
#pragma unroll
        for (int m = 0; m < 4; ++m) { bf16_t* rowp = O + (size_t)(row0 + ai * HALF + m * 16) * ldc + col0;
            f32x4 a0 = acc[ai][0][m][0], a1 = acc[ai][0][m][1]; const f32x4 b0 = acc[ai][1][m][0], b1 = acc[ai][1][m][1];
            if (SILU) {
#pragma unroll
                for (int e = 0; e < 4; ++e) { a0[e] = silu_f(a0[e]); a1[e] = silu_f(a1[e]); } }
            a0 = a0 * b0; a1 = a1 * b1;
            u32x4 w; w.x = cvtpk(a0[0], a0[1]); w.y = cvtpk(a0[2], a0[3]); w.z = cvtpk(a1[0], a1[1]); w.w = cvtpk(a1[2], a1[3]);
            *(u32x4*)rowp = w; }
}
struct EpiSwiGLU {
    static constexpr bool PERM = true, AFTER_DRAIN = false;
    bf16_t* H; int ldh;
    __device__ __forceinline__ void operator()(const f32x4 (&acc)[2][2][4][2], const Unit& u, int wr, int wc, int fr, int fq) const {
        store_tile_prod<true>(acc, H, ldh, u.pm * BM + wr * 64 + fr, u.pn * HALF + wc * 32 + 8 * fq);
    }
};
struct EpiResid {
    static constexpr bool PERM = false, AFTER_DRAIN = false;
    const float* base_l; const float* base_c; float* out; const float* gate_l; const float* gate_c; float coef; int Lrows, ld;
    __device__ __forceinline__ void operator()(const f32x4 (&acc)[2][2][4][2], const Unit& u, int wr, int wc, int fr, int fq) const {
        const bool isc = (u.pm * BM >= Lrows);
        const float* base = isc ? base_c : base_l; const float* gate = isc ? gate_c : gate_l;
        const int row0 = u.pm * BM + wr * 64 + fr, brow0 = isc ? row0 - Lrows : row0, col0 = u.pn * BM + wc * 32 + 4 * fq;
        f32x4 gv[2][2];
#pragma unroll
        for (int bj = 0; bj < 2; ++bj)
#pragma unroll
            for (int n = 0; n < 2; ++n) gv[bj][n] = *(const f32x4*)(gate + col0 + bj * HALF + n * 16) * coef;
#pragma unroll
        for (int ai = 0; ai < 2; ++ai)
#pragma unroll
            for (int m = 0; m < 4; ++m) { const size_t boff = (size_t)(brow0 + ai * HALF + m * 16) * ld + col0, ooff = (size_t)(row0 + ai * HALF + m * 16) * ld + col0;
#pragma unroll
                for (int bj = 0; bj < 2; ++bj)
#pragma unroll
                    for (int n = 0; n < 2; ++n) { const f32x4 b = *(const f32x4*)(base + boff + bj * HALF + n * 16);
                        *(f32x4*)(out + ooff + bj * HALF + n * 16) = b + gv[bj][n] * acc[ai][bj][m][n]; }
                if (m & 1) asm volatile("" ::: "memory"); }
    }
};
struct EpiWin {
    static constexpr bool PERM = true, AFTER_DRAIN = false;
    unsigned char* qbase; bf16_t* Vt; float qscale; int vt_ld; unsigned k_off, u_off;
    __device__ __forceinline__ void operator()(const f32x4 (&acc)[2][2][4][2], const Unit& u, int wr, int wc, int fr, int fq) const {
        const int pn = u.pn, row0 = u.pm * BM + wr * 64 + fr, lc0 = wc * 32 + 8 * fq;
        if (pn == 4 || pn == 5) {
            const int c0 = (pn - 4) * BM + lc0;
#pragma unroll
            for (int ai = 0; ai < 2; ++ai)
#pragma unroll
                for (int m = 0; m < 4; ++m) { const int tok = row0 + ai * HALF + m * 16;
#pragma unroll
                    for (int bj = 0; bj < 2; ++bj)
#pragma unroll
                        for (int n = 0; n < 2; ++n) { const f32x4 v = acc[ai][bj][m][n]; const unsigned w0 = cvtpk(v[0], v[1]), w1 = cvtpk(v[2], v[3]);
                            bf16_t* p = Vt + (size_t)(c0 + bj * HALF + 4 * n) * vt_ld + tok;
                            p[0] = (bf16_t)(w0 & 0xffffu); p[vt_ld] = (bf16_t)(w0 >> 16); p[2 * (size_t)vt_ld] = (bf16_t)(w1 & 0xffffu); p[3 * (size_t)vt_ld] = (bf16_t)(w1 >> 16); } }
        } else {
            const unsigned off = (pn >= 2 ? k_off : 0u) + (pn >= 6 ? u_off - k_off : 0u);
            bf16_t* dst = (bf16_t*)(qbase + off);
            store_tile_bf16(acc, dst, 512, row0, (pn & 1) * BM + lc0, pn < 2 ? qscale : 1.0f);
        }
    }
};
struct EpiCin {
    static constexpr bool PERM = true, AFTER_DRAIN = false;
    bf16_t *BG, *Z;
    __device__ __forceinline__ void operator()(const f32x4 (&acc)[2][2][4][2], const Unit& u, int wr, int wc, int fr, int fq) const {
        const int row0 = u.pm * BM + wr * 64 + fr, lc0 = wc * 32 + 8 * fq;
        if (u.pn < 4) store_tile_bf16(acc, BG, 1024, row0, u.pn * BM + lc0, 1.0f);
        else store_tile_prod<false>(acc, Z, 1024, row0, (u.pn - 4) * HALF + lc0);
    }
};
struct WinOrder : StaticOrder {
    __device__ bool next(int i, Unit& u) const {
        const long Lx = (long)i * G + c;
        if (Lx < nwg) return StaticOrder::next(i, u);
        if (Lx < nwg + 4) { u.pm = nM; u.pn = 2 + (int)(Lx - nwg); return true; }
        return false;
    }
};

template <class Epi, class Sched, bool ALIGN_EPI = false, bool SP2 = false>
__device__ __forceinline__ void gemm_phase(PG8_LAS unsigned char* lds, const Gemm g, const Sched& S, const Epi& E) {
    const int tid = threadIdx.x, wid = __builtin_amdgcn_readfirstlane(tid >> 6), lane = tid & 63, wr = wid >> 2, wc = wid & 3, fr = lane & 15, fq = lane >> 4;
    const int K = g.K, nt = K / BK;
    unsigned voffA[2], voffB[2];
#pragma unroll
    for (int i = 0; i < 2; ++i) { int R, C; stage_rc(tid * 16 + i * 8192, R, C); const int Rb = Epi::PERM ? ((R & ~31) + perm32(R & 31)) : R;
        voffA[i] = (unsigned)(R * K + C) * 2u; voffB[i] = (unsigned)(Rb * K + C) * 2u; }
    const size_t kstep = (size_t)(BK * 2);
    const size_t hstep = (size_t)HALF * K * 2;
    const size_t tstep = 2 * hstep;
    const unsigned ldsw = (unsigned)wid * 1024u;
    const int aoff = lds_byte(wr * 64 + fr, fq * 8), boff = lds_byte(wc * 32 + fr, fq * 8);
#define PG8_SA(b, h) (((b) * 2 + (h)) * HTB)
#define PG8_SB(b, h) ((4 + (b) * 2 + (h)) * HTB)
#define PG8_STAGE(bufoff, gbase, voff) do { _Pragma("unroll") for (int _i = 0; _i < 2; ++_i) \
        __builtin_amdgcn_global_load_lds((const unsigned*)((const char*)(gbase) + (voff)[_i]), (PG8_LAS unsigned*)(lds + (bufoff) + ldsw + _i * 8192), 16, 0, 0); } while (0)
#define PG8_LDA(dst, b, h) do { _Pragma("unroll") for (int m = 0; m < 4; ++m) _Pragma("unroll") for (int k = 0; k < 2; ++k) dst[m][k] = *(const PG8_LAS bf16x8*)(lds + PG8_SA(b, h) + aoff + m * 2048 + k * 1024); } while (0)
#define PG8_LDB(dst, b, h) do { _Pragma("unroll") for (int n = 0; n < 2; ++n) _Pragma("unroll") for (int k = 0; k < 2; ++k) dst[n][k] = *(const PG8_LAS bf16x8*)(lds + PG8_SB(b, h) + boff + n * 2048 + k * 1024); } while (0)
#define PG8_MMA(ai, bj, At, Bt) do { __builtin_amdgcn_s_setprio(1); _Pragma("unroll") for (int m = 0; m < 4; ++m) _Pragma("unroll") for (int n = 0; n < 2; ++n) _Pragma("unroll") for (int k = 0; k < 2; ++k) \
        acc[ai][bj][m][n] = __builtin_amdgcn_mfma_f32_16x16x32_bf16(Bt[n][k], At[m][k], acc[ai][bj][m][n], 0, 0, 0); __builtin_amdgcn_s_setprio(0); } while (0)
#define PG8_WAIT_V(n) asm volatile("s_waitcnt vmcnt(" #n ")" ::: "memory")
#define PG8_WAIT_L(n) asm volatile("s_waitcnt lgkmcnt(" #n ")" ::: "memory")
#define PG8_BAR __builtin_amdgcn_s_barrier()
#define PG8_SCHED __builtin_amdgcn_sched_barrier(0)
    Unit cur, nxt; int ui = 0;
    if (!S.next(0, cur)) return;
    f32x4 acc[2][2][4][2];
#pragma unroll
    for (int a = 0; a < 2; ++a)
#pragma unroll
        for (int b = 0; b < 2; ++b)
#pragma unroll
            for (int m = 0; m < 4; ++m)
#pragma unroll
                for (int n = 0; n < 2; ++n) acc[a][b][m][n] = (f32x4){0.f, 0.f, 0.f, 0.f};
    bf16x8 At[4][2], B0[2][2], B1[2][2];
    const char* cA = (const char*)g.A + (size_t)cur.pm * tstep; const char* cB = (const char*)g.Bt + (size_t)cur.pn * tstep;
    S.a_ready(cur);
    if constexpr (SP2) {
        PG8_STAGE(PG8_SB(0, 0), cB, voffB); PG8_STAGE(PG8_SB(0, 1), cB + hstep, voffB); PG8_STAGE(PG8_SA(0, 0), cA, voffA); PG8_STAGE(PG8_SA(0, 1), cA + hstep, voffA);
        if (wr == 1) PG8_BAR;
        PG8_WAIT_V(2); PG8_BAR;
        PG8_STAGE(PG8_SB(1, 0), cB + kstep, voffB); PG8_STAGE(PG8_SA(1, 0), cA + kstep, voffA); PG8_STAGE(PG8_SB(1, 1), cB + hstep + kstep, voffB);
        PG8_WAIT_V(6); PG8_BAR;
    } else {
        PG8_STAGE(PG8_SB(0, 0), cB, voffB); PG8_STAGE(PG8_SA(0, 0), cA, voffA); PG8_STAGE(PG8_SB(0, 1), cB + hstep, voffB); PG8_STAGE(PG8_SA(0, 1), cA + hstep, voffA);
        if (wr == 1) PG8_BAR;
        PG8_WAIT_V(4); PG8_BAR;
        PG8_STAGE(PG8_SB(1, 0), cB + kstep, voffB); PG8_STAGE(PG8_SA(1, 0), cA + kstep, voffA); PG8_STAGE(PG8_SB(1, 1), cB + hstep + kstep, voffB);
        PG8_WAIT_V(6); PG8_BAR;
    }
    for (;;) {
        const bool has_next = S.next(ui + 1, nxt);
        const char* nA = has_next ? (const char*)g.A + (size_t)nxt.pm * tstep : cA; const char* nB = has_next ? (const char*)g.Bt + (size_t)nxt.pn * tstep : cB;
        for (int t = 0; t < nt; t += 2) {
            const bool last = (t == nt - 2);
            const char* a1 = cA + (size_t)(t + 1) * kstep;
            const char* a2 = last ? nA : cA + (size_t)(t + 2) * kstep; const char* b2 = last ? nB : cB + (size_t)(t + 2) * kstep;
            const char* a3 = a2 + kstep; const char* b3 = b2 + kstep;
            if (last && has_next) S.a_ready(nxt);
            if constexpr (SP2) {
            PG8_LDB(B0, 0, 0); PG8_LDB(B1, 0, 1); PG8_SCHED; PG8_LDA(At, 0, 0); PG8_STAGE(PG8_SA(1, 1), a1 + hstep, voffA);
            PG8_WAIT_V(8); PG8_WAIT_L(0); PG8_BAR; PG8_MMA(0, 0, At, B0); PG8_MMA(0, 1, At, B1); PG8_BAR; PG8_SCHED;
            PG8_LDA(At, 0, 1); PG8_STAGE(PG8_SB(0, 0), b2, voffB); PG8_STAGE(PG8_SB(0, 1), b2 + hstep, voffB); PG8_STAGE(PG8_SA(0, 0), a2, voffA);
            PG8_WAIT_V(8); PG8_WAIT_L(0); PG8_BAR; PG8_MMA(1, 0, At, B0); PG8_MMA(1, 1, At, B1); PG8_BAR; PG8_SCHED;
            PG8_LDB(B0, 1, 0); PG8_LDB(B1, 1, 1); PG8_SCHED; PG8_LDA(At, 1, 0); PG8_STAGE(PG8_SA(0, 1), a2 + hstep, voffA);
            PG8_WAIT_V(8); PG8_WAIT_L(0); PG8_BAR; PG8_MMA(0, 0, At, B0); PG8_MMA(0, 1, At, B1); PG8_BAR; PG8_SCHED;
            PG8_LDA(At, 1, 1); PG8_STAGE(PG8_SB(1, 0), b3, voffB); PG8_STAGE(PG8_SB(1, 1), b3 + hstep, voffB); PG8_STAGE(PG8_SA(1, 0), a3, voffA);
            PG8_WAIT_V(8); PG8_WAIT_L(0); PG8_BAR; PG8_MMA(1, 0, At, B0); PG8_MMA(1, 1, At, B1); PG8_BAR; PG8_SCHED;
            } else {
            PG8_LDB(B0, 0, 0); PG8_SCHED; PG8_LDA(At, 0, 0); PG8_STAGE(PG8_SA(1, 1), a1 + hstep, voffA);
            PG8_WAIT_L(8); PG8_BAR; PG8_WAIT_L(0); PG8_MMA(0, 0, At, B0); PG8_BAR; PG8_SCHED;
            PG8_LDB(B1, 0, 1); PG8_STAGE(PG8_SB(0, 0), b2, voffB);
            PG8_BAR; PG8_WAIT_L(0); PG8_MMA(0, 1, At, B1); PG8_BAR;
            PG8_LDA(At, 0, 1); PG8_STAGE(PG8_SA(0, 0), a2, voffA);
            PG8_BAR; PG8_WAIT_L(0); PG8_MMA(1, 0, At, B0); PG8_BAR; PG8_SCHED;
            PG8_STAGE(PG8_SB(0, 1), b2 + hstep, voffB);
            PG8_WAIT_V(6); PG8_BAR; PG8_MMA(1, 1, At, B1); PG8_BAR;
            PG8_LDB(B0, 1, 0); PG8_SCHED; PG8_LDA(At, 1, 0); PG8_STAGE(PG8_SA(0, 1), a2 + hstep, voffA);
            PG8_WAIT_L(8); PG8_BAR; PG8_WAIT_L(0); PG8_MMA(0, 0, At, B0); PG8_BAR; PG8_SCHED;
            PG8_LDB(B1, 1, 1); PG8_STAGE(PG8_SB(1, 0), b3, voffB);
            PG8_BAR; PG8_WAIT_L(0); PG8_MMA(0, 1, At, B1); PG8_BAR;
            PG8_LDA(At, 1, 1); PG8_STAGE(PG8_SA(1, 0), a3, voffA);
            PG8_BAR; PG8_WAIT_L(0); PG8_MMA(1, 0, At, B0); PG8_BAR; PG8_SCHED;
            PG8_STAGE(PG8_SB(1, 1), b3 + hstep, voffB);
            PG8_WAIT_V(6); PG8_BAR; PG8_MMA(1, 1, At, B1); PG8_BAR;
            }
        }
        if constexpr (ALIGN_EPI) { if (wr == 0) PG8_BAR; }
        if constexpr (!Epi::AFTER_DRAIN) { E(acc, cur, wr, wc, fr, fq); S.done(cur); }
        if (!has_next) break;
#pragma unroll
        for (int a = 0; a < 2; ++a)
#pragma unroll
            for (int b = 0; b < 2; ++b)
#pragma unroll
                for (int m = 0; m < 4; ++m)
#pragma unroll
                    for (int n = 0; n < 2; ++n) acc[a][b][m][n] = (f32x4){0.f, 0.f, 0.f, 0.f};
        cur = nxt; cA = nA; cB = nB; ++ui;
        if constexpr (ALIGN_EPI) { if (wr == 1) PG8_BAR; }
    }
    PG8_WAIT_V(0);
    if constexpr (!ALIGN_EPI) { if (wr == 0) PG8_BAR; }
    PG8_BAR;
    if constexpr (Epi::AFTER_DRAIN) { E.fused(acc, cur, wr, wc, fr, fq, lds, wid, lane); S.done(cur); }
#undef PG8_SA
#undef PG8_SB
#undef PG8_STAGE
#undef PG8_LDA
#undef PG8_LDB
#undef PG8_MMA
#undef PG8_WAIT_V
#undef PG8_WAIT_L
#undef PG8_BAR
#undef PG8_SCHED
}
}
#define GAS __attribute__((address_space(1)))
#define LAS __attribute__((address_space(3)))
typedef unsigned short bf16;
typedef unsigned v4u __attribute__((ext_vector_type(4)));
typedef float f32x4 __attribute__((ext_vector_type(4)));
typedef short bf16x8 __attribute__((ext_vector_type(8)));
typedef GAS unsigned gu32;
typedef GAS unsigned long long gu64;
#define RLX_AGENT __ATOMIC_RELAXED, __HIP_MEMORY_SCOPE_AGENT
#define LDS_WAIT() asm volatile("s_waitcnt lgkmcnt(0)" ::: "memory")
#define VM_WAIT() asm volatile("s_waitcnt vmcnt(0)" ::: "memory")
__device__ __forceinline__ unsigned long long rt() { return __builtin_amdgcn_s_memrealtime(); }
__device__ __forceinline__ unsigned f2bf(float f) { unsigned u = __builtin_bit_cast(unsigned, f); return (u + 0x7fffu + ((u >> 16) & 1u)) >> 16; }
__device__ __forceinline__ unsigned pk2(float lo, float hi) { return f2bf(lo) | (f2bf(hi) << 16); }

#define XB_TMO      128
#define XB_XCNT(j)  (256  + 64 * (j))
#define XB_XSUB(j)  (1280 + 64 * (j))
#define XB_XGEN(j)  (2304 + 64 * (j))
#define XB_TOP      3328
#define XB_TOPGEN   3392
#define XCD_BAR_WORDS 3456
#define XB_SPIN_CAP (1u << 18)

__device__ __forceinline__ unsigned xb_ld(unsigned* p)              { return __hip_atomic_load(p, __ATOMIC_RELAXED, __HIP_MEMORY_SCOPE_AGENT); }
__device__ __forceinline__ unsigned xb_add(unsigned* p, unsigned v) { return __hip_atomic_fetch_add(p, v, __ATOMIC_RELAXED, __HIP_MEMORY_SCOPE_AGENT); }
__device__ __forceinline__ unsigned xb_xcc_id() { return (unsigned)__builtin_amdgcn_s_getreg((3 << 11) | 20) & 0xFu; }
#define XB_SPIN(cond, bar) do { unsigned _sp = 0; while (cond) { __builtin_amdgcn_s_sleep(1); \
    if ((++_sp & 255u) == 0u) { if (xb_ld(&(bar)[XB_TMO])) break; if (_sp > XB_SPIN_CAP) { atomicAdd(&(bar)[XB_TMO], 1u); break; } } } } while (0)

struct XcdBarrier {
    unsigned* bar; unsigned x;
    volatile LAS unsigned* st;
};

__device__ __forceinline__ XcdBarrier xcd_barrier_post(unsigned* bar, volatile LAS unsigned* st) {
    XcdBarrier b; b.bar = bar; b.x = xb_xcc_id(); b.st = st;
    if (threadIdx.x == 0) (void)xb_add(&bar[XB_XCNT(b.x)], 1u);
    return b;
}
__device__ __forceinline__ void xcd_barrier_complete(unsigned* bar, unsigned x, unsigned& nloc, unsigned& nx) {
    const unsigned G = gridDim.x * gridDim.y * gridDim.z;
    unsigned sum, cnt, mine, sp = 0u;
    for (;;) {
        sum = 0u; cnt = 0u; mine = 0u;
#pragma unroll
        for (unsigned j = 0; j < 16; ++j) { const unsigned c = xb_ld(&bar[XB_XCNT(j)]); sum += c; cnt += (c > 0u) ? 1u : 0u; mine = (j == x) ? c : mine; }
        if (sum == G) break;
        __builtin_amdgcn_s_sleep(1);
        if ((++sp & 255u) == 0u) { if (xb_ld(&bar[XB_TMO])) break; if (sp > XB_SPIN_CAP) { atomicAdd(&bar[XB_TMO], 1u); break; } }
    }
    nloc = mine > 0u ? mine : 1u; nx = cnt > 0u ? cnt : 1u;
}

__device__ __forceinline__ void xcd_barrier(const XcdBarrier& b) {
    asm volatile("s_waitcnt vmcnt(0)" ::: "memory");
    __syncthreads();
    if (threadIdx.x == 0) {
        unsigned* bar = b.bar;
        __builtin_amdgcn_s_waitcnt(0);
        unsigned nloc = b.st[0], nx = b.st[1];
        if (nloc == 0u) { xcd_barrier_complete(bar, b.x, nloc, nx); b.st[0] = nloc; b.st[1] = nx; }
        const unsigned old = xb_add(&bar[XB_XSUB(b.x)], 1u);
        const unsigned gen = old / nloc;
        if (old + 1u == (gen + 1u) * nloc) {
            __builtin_amdgcn_fence(__ATOMIC_RELEASE, "agent");
            asm volatile("s_waitcnt vmcnt(0)" ::: "memory");
            const unsigned og = xb_add(&bar[XB_TOP], 1u);
            const unsigned tg = og / nx;
            if (og + 1u == (tg + 1u) * nx) xb_add(&bar[XB_TOPGEN], 1u);
            else XB_SPIN(xb_ld(&bar[XB_TOPGEN]) == tg, bar);
            __builtin_amdgcn_fence(__ATOMIC_ACQUIRE, "agent");
            xb_add(&bar[XB_XGEN(b.x)], 1u);
            asm volatile("s_waitcnt vmcnt(0)" ::: "memory");
        } else {
            XB_SPIN(xb_ld(&bar[XB_XGEN(b.x)]) == gen, bar);
            __builtin_amdgcn_fence(__ATOMIC_ACQUIRE, "agent");
            asm volatile("s_waitcnt vmcnt(0)" ::: "memory");
        }
    }
    __syncthreads();
}
typedef unsigned u32x4 __attribute__((ext_vector_type(4)));
__device__ __forceinline__ unsigned cvtpk2(float lo, float hi) { return pg8::cvtpk(lo, hi); }

constexpr int NWAVES = 8;
constexpr int D = 1024, LSEQ = 16384, NCTX = 256, MT = LSEQ + NCTX, DFF = 2816, NMOD = 9, MODW = NMOD * D;
constexpr int GRID_W = 64, NHEADS = 8, HD = 64, NAW = 512;
constexpr float RMS_EPS = 1e-6f, LOG2E = 1.4426950408889634f;
constexpr int N_PHASES = 22;

constexpr size_t MiB = 1u << 20;
constexpr size_t WS_CTL = 0, CTL_ZERO_BYTES = 1 * MiB;
constexpr size_t WS_MOD = 1 * MiB;
constexpr size_t WS_W13T = 2 * MiB, W13T_BYTES = (size_t)2 * DFF * D * 2;
constexpr size_t WS_W2T = 46 * MiB, W2T_BYTES = (size_t)D * DFF * 2;
constexpr size_t WS_WINT = 68 * MiB, WS_WOUTT = 72 * MiB, WS_CINT = 74 * MiB, WS_COUTT = 80 * MiB;
constexpr size_t WS_XRES = 82 * MiB;
constexpr size_t WS_ACT = 147 * MiB;
constexpr size_t WS_H = 180 * MiB;
constexpr size_t WS_Q = 180 * MiB, WS_K = 196 * MiB, WS_VT = 213 * MiB, WS_U = 230 * MiB;
constexpr size_t WS_BG = 180 * MiB, WS_Z = 212 * MiB;
constexpr size_t WS_END = 270 * MiB;
static_assert(WS_W13T + 4 * W13T_BYTES <= WS_W2T && WS_W2T + 4 * W2T_BYTES <= WS_WINT && WS_XRES + (size_t)MT * D * 4 <= WS_ACT && WS_ACT + (size_t)MT * D * 2 <= WS_H && WS_H + (size_t)MT * DFF * 2 <= WS_END, "d_ws map");
static_assert(WS_K + (size_t)MT * 512 * 2 <= WS_VT && WS_VT + (size_t)MT * 512 * 2 <= WS_U && WS_U + (size_t)LSEQ * 512 * 2 <= WS_END, "mixer overlay map");
constexpr int CW_BAR = 4096;

constexpr int RING_OFF = 0, RING_BYTES = 131072;
constexpr int LDSCTL_OFF = RING_BYTES, MISC_OFF = LDSCTL_OFF + 320;
constexpr int STAB_OFF = RING_BYTES + 1024;
constexpr int LDS_BYTES = 147456;
static_assert(STAB_OFF + 8192 <= LDS_BYTES, "LDS map");

struct Frame {
    LAS unsigned char* lds;
    volatile LAS unsigned* MISC;
    gu32* ctl;
    int tid, lane, wave, vcu, G;
    const float* in[18];
    float* out; unsigned char* ws;
};
__device__ __forceinline__ float wave_sum(float v) {
#pragma unroll
    for (int o = 1; o < 64; o <<= 1) v += __shfl_xor(v, o);
    return v;
}

__device__ __forceinline__ void p0_transpose_item(const float* W, int K, int ldn, bf16* WT, int k0, int n0, int drow0, LAS float* scr, int lane) {
    { const int nq = lane & 7, kk0 = lane >> 3;
        const GAS float* src = (const GAS float*)(W + (size_t)(k0 + kk0) * ldn + n0 + 4 * nq);
        f32x4 v[8];
#pragma unroll
        for (int i = 0; i < 8; ++i) v[i] = *(const GAS f32x4*)(src + (size_t)(8 * i) * ldn);
#pragma unroll
        for (int i = 0; i < 8; ++i) { LAS float* d = scr + (kk0 + 8 * i) * 33 + 4 * nq; d[0] = v[i].x; d[1] = v[i].y; d[2] = v[i].z; d[3] = v[i].w; }
    }
    LDS_WAIT(); asm volatile("" ::: "memory");
    const int c = lane & 7;
#pragma unroll
    for (int j = 0; j < 4; ++j) { const int n = (lane >> 3) + 8 * j; const LAS float* s = scr + (8 * c) * 33 + n;
        v4u o; o.x = pk2(s[0 * 33], s[1 * 33]); o.y = pk2(s[2 * 33], s[3 * 33]); o.z = pk2(s[4 * 33], s[5 * 33]); o.w = pk2(s[6 * 33], s[7 * 33]);
        *(GAS v4u*)(WT + (size_t)(drow0 + n) * K + k0 + 8 * c) = o; }
    LDS_WAIT(); asm volatile("" ::: "memory");
}
__device__ __forceinline__ int map_swiglu(int n0) { const int half = n0 / DFF, hx = n0 % DFF; return 256 * (hx / 128) + 128 * half + (hx % 128); }
__device__ __forceinline__ int map_cin(int n0) { if (n0 < D) return n0; const int part = (n0 - D) / D, ch = (n0 - D) % D; return D + 256 * (ch / 128) + 128 * part + (ch % 128); }

__device__ __forceinline__ void p0_prologue(Frame& F) {
    LAS float* scr = (LAS float*)(F.lds + RING_OFF + F.wave * 16384);
    LAS float* stab = (LAS float*)(F.lds + STAB_OFF);
    const int gw = F.vcu * NWAVES + F.wave, NGW = F.G * NWAVES, lane = F.lane;
    for (int k = F.tid; k < D; k += NWAVES * 64) { const float a = F.in[1][k], b = F.in[3][k]; stab[k] = a / (1.0f + expf(-a)); stab[D + k] = b / (1.0f + expf(-b)); }
    __syncthreads();
    {
        float* mv = (float*)(F.ws + WS_MOD);
        constexpr int NCH = MODW / 16;
        for (int it = gw; it < 2 * NCH; it += NGW) {
            const int layer = it / NCH, col0 = (it % NCH) * 16, cq = lane & 3, kr = lane >> 2;
            const GAS float* W = (const GAS float*)(F.in[4] + (size_t)layer * D * MODW + col0 + 4 * cq);
            f32x4 al = {0.f, 0.f, 0.f, 0.f}, ac = {0.f, 0.f, 0.f, 0.f};
#pragma unroll 8
            for (int i = 0; i < 64; ++i) { const int k = kr + 16 * i; const f32x4 w = *(const GAS f32x4*)(W + (size_t)k * MODW); al += w * stab[k]; ac += w * stab[D + k]; }
#pragma unroll
            for (int e = 0; e < 4; ++e) {
#pragma unroll
                for (int o = 4; o < 64; o <<= 1) { al[e] += __shfl_xor(al[e], o); ac[e] += __shfl_xor(ac[e], o); } }
            if (lane < 4) {
                const f32x4 b = *(const f32x4*)(F.in[5] + (size_t)layer * MODW + col0 + 4 * cq);
                if (layer == 0) { *(f32x4*)(mv + col0 + 4 * cq) = al + b; *(f32x4*)(mv + MODW + col0 + 4 * cq) = ac + b; }
                else *(f32x4*)(mv + 2 * MODW + col0 + 4 * cq) = al + b;
            }
        }
    }
    if (F.wave == 0) {
        bf16* WINt = (bf16*)(F.ws + WS_WINT);
        for (int it = F.vcu; it < 4 * 64; it += F.G) {
            const int g = it >> 6, k0 = (it & 63) * 16;
#pragma unroll
            for (int i = 0; i < 32; ++i) { const int e = i * 64 + lane, kk = e >> 7, j = e & 127; scr[e] = F.in[9][(size_t)(k0 + kk) * 2048 + 1536 + g * 128 + j]; }
            LDS_WAIT(); asm volatile("" ::: "memory");
            float a0[16], a1[16];
#pragma unroll
            for (int kk = 0; kk < 16; ++kk) { a0[kk] = 0.f; a1[kk] = 0.f; }
            const GAS float* P = (const GAS float*)(F.in[12] + (size_t)g * 128 * 128);
            for (int jc = 0; jc < 128; jc += 16) {
                float p0[16], p1[16];
#pragma unroll
                for (int jj = 0; jj < 16; ++jj) { p0[jj] = P[(jc + jj) * 128 + lane]; p1[jj] = P[(jc + jj) * 128 + 64 + lane]; }
#pragma unroll
                for (int jj = 0; jj < 16; ++jj) {
#pragma unroll
                    for (int kk = 0; kk < 16; ++kk) { const float a = scr[kk * 128 + jc + jj]; a0[kk] += a * p0[jj]; a1[kk] += a * p1[jj]; } }
            }
            const float s0 = F.in[13][g * 128 + lane], s1 = F.in[13][g * 128 + 64 + lane];
            v4u o0, o1, o2, o3;
            o0.x = pk2(a0[0] * s0, a0[1] * s0); o0.y = pk2(a0[2] * s0, a0[3] * s0); o0.z = pk2(a0[4] * s0, a0[5] * s0); o0.w = pk2(a0[6] * s0, a0[7] * s0);
            o1.x = pk2(a0[8] * s0, a0[9] * s0); o1.y = pk2(a0[10] * s0, a0[11] * s0); o1.z = pk2(a0[12] * s0, a0[13] * s0); o1.w = pk2(a0[14] * s0, a0[15] * s0);
            o2.x = pk2(a1[0] * s1, a1[1] * s1); o2.y = pk2(a1[2] * s1, a1[3] * s1); o2.z = pk2(a1[4] * s1, a1[5] * s1); o2.w = pk2(a1[6] * s1, a1[7] * s1);
            o3.x = pk2(a1[8] * s1, a1[9] * s1); o3.y = pk2(a1[10] * s1, a1[11] * s1); o3.z = pk2(a1[12] * s1, a1[13] * s1); o3.w = pk2(a1[14] * s1, a1[15] * s1);
            GAS v4u* d0 = (GAS v4u*)(WINt + (size_t)(1536 + g * 128 + lane) * D + k0);
            GAS v4u* d1 = (GAS v4u*)(WINt + (size_t)(1536 + g * 128 + 64 + lane) * D + k0);
            d0[0] = o0; d0[1] = o1; d1[0] = o2; d1[1] = o3;
            LDS_WAIT(); asm volatile("" ::: "memory");
        }
    }
    {
        constexpr int I_13 = (D / 64) * (2 * DFF / 32), I_2 = (DFF / 64) * (D / 32), I_IN = (D / 64) * (1536 / 32), I_SQ = (D / 64) * (D / 32), I_CI = (D / 64) * (3 * D / 32);
        constexpr int NITEMS = 4 * I_13 + 4 * I_2 + I_IN + I_SQ + I_CI + I_SQ;
        for (int it = gw; it < NITEMS; it += NGW) {
            int r = it;
            if (r < 4 * I_13) { const int mi = r / I_13, q = r % I_13, nblk = 2 * DFF / 32, kb = q / nblk, nb = q % nblk;
                p0_transpose_item(F.in[7] + (size_t)mi * D * 2 * DFF, D, 2 * DFF, (bf16*)(F.ws + WS_W13T + mi * W13T_BYTES), 64 * kb, 32 * nb, map_swiglu(32 * nb), scr, lane); continue; } r -= 4 * I_13;
            if (r < 4 * I_2) { const int mi = r / I_2, q = r % I_2, nblk = D / 32, kb = q / nblk, nb = q % nblk;
                p0_transpose_item(F.in[8] + (size_t)mi * DFF * D, DFF, D, (bf16*)(F.ws + WS_W2T + mi * W2T_BYTES), 64 * kb, 32 * nb, 32 * nb, scr, lane); continue; } r -= 4 * I_2;
            if (r < I_IN) { const int nblk = 1536 / 32, kb = r / nblk, nb = r % nblk;
                p0_transpose_item(F.in[9], D, 2048, (bf16*)(F.ws + WS_WINT), 64 * kb, 32 * nb, 32 * nb, scr, lane); continue; } r -= I_IN;
            if (r < I_SQ) { const int nblk = D / 32, kb = r / nblk, nb = r % nblk;
                p0_transpose_item(F.in[10], D, D, (bf16*)(F.ws + WS_WOUTT), 64 * kb, 32 * nb, 32 * nb, scr, lane); continue; } r -= I_SQ;
            if (r < I_CI) { const int nblk = 3 * D / 32, kb = r / nblk, nb = r % nblk;
                p0_transpose_item(F.in[14], D, 3 * D, (bf16*)(F.ws + WS_CINT), 64 * kb, 32 * nb, map_cin(32 * nb), scr, lane); continue; } r -= I_CI;
            { const int nblk = D / 32, kb = r / nblk, nb = r % nblk;
                p0_transpose_item(F.in[16], D, D, (bf16*)(F.ws + WS_COUTT), 64 * kb, 32 * nb, 32 * nb, scr, lane); }
        }
    }
}

__device__ __forceinline__ void norm_rows_bf16(Frame& F, const float* src, bf16* dst, int nrows, const float* g, const float* shift, const float* scale) {
    const int gw = F.vcu * NWAVES + F.wave, NGW = F.G * NWAVES, lane = F.lane;
    f32x4 A[4], B[4];
#pragma unroll
    for (int j = 0; j < 4; ++j) { const int c = 4 * lane + 256 * j; const f32x4 gv = *(const f32x4*)(g + c), sc = *(const f32x4*)(scale + c); A[j] = gv * (sc + 1.0f); B[j] = *(const f32x4*)(shift + c); }
    for (int m = gw; m < nrows; m += NGW) {
        const GAS f32x4* xr = (const GAS f32x4*)(src + (size_t)m * D) + lane;
        f32x4 v[4]; float s2 = 0.f;
#pragma unroll
        for (int j = 0; j < 4; ++j) { v[j] = xr[64 * j]; s2 += (v[j].x * v[j].x + v[j].y * v[j].y) + (v[j].z * v[j].z + v[j].w * v[j].w); }
        const float rstd = 1.0f / sqrtf(wave_sum(s2) * (1.0f / D) + RMS_EPS);
        GAS unsigned long long* o8 = (GAS unsigned long long*)(dst + (size_t)m * D) + lane;
#pragma unroll
        for (int j = 0; j < 4; ++j) { const f32x4 y = v[j] * rstd * A[j] + B[j]; o8[64 * j] = (unsigned long long)pk2(y.x, y.y) | ((unsigned long long)pk2(y.z, y.w) << 32); }
    }
}
__device__ __forceinline__ void norm_rows_final(Frame& F, const float* src, float* dst, int nrows, const float* g) {
    const int gw = F.vcu * NWAVES + F.wave, NGW = F.G * NWAVES, lane = F.lane;
    f32x4 A[4];
#pragma unroll
    for (int j = 0; j < 4; ++j) A[j] = *(const f32x4*)(g + 4 * lane + 256 * j);
    for (int m = gw; m < nrows; m += NGW) {
        const GAS f32x4* xr = (const GAS f32x4*)(src + (size_t)m * D) + lane;
        f32x4 v[4]; float s2 = 0.f;
#pragma unroll
        for (int j = 0; j < 4; ++j) { v[j] = xr[64 * j]; s2 += (v[j].x * v[j].x + v[j].y * v[j].y) + (v[j].z * v[j].z + v[j].w * v[j].w); }
        const float rstd = 1.0f / sqrtf(wave_sum(s2) * (1.0f / D) + RMS_EPS);
        GAS f32x4* o = (GAS f32x4*)(dst + (size_t)m * D) + lane;
#pragma unroll
        for (int j = 0; j < 4; ++j) o[64 * j] = v[j] * rstd * A[j];
    }
}

typedef float f32x16 __attribute__((ext_vector_type(16)));
typedef unsigned u32x2 __attribute__((ext_vector_type(2)));
__device__ __forceinline__ int crow(int r, int hi) { return (r & 3) + 8 * (r >> 2) + 4 * hi; }
__device__ __forceinline__ float bf_lo(unsigned w) { return __uint_as_float(w << 16); }
__device__ __forceinline__ float bf_hi(unsigned w) { return __uint_as_float(w & 0xffff0000u); }

struct AttKV { bf16x8 k[4]; u32x2 v[2][2][2]; };
struct AttCtx { const GAS bf16* Kq; const GAS bf16* Vh; int rs, ch, q, hi; };
__device__ __forceinline__ void att_load(AttKV& kv, const AttCtx& c, int b) {
    int ktok, vb0, vb1;
    if (b < 8) { const int tok0 = LSEQ + 32 * b; ktok = tok0 + c.q; vb0 = tok0; vb1 = tok0 + 16; }
    else { const int wb = b - 8, rp = wb / 3, cc = wb - 3 * rp, kr0 = c.rs + 2 * rp, c16 = 16 * c.ch + 16 * cc; ktok = (kr0 + (c.q >> 4)) * GRID_W + c16 + (c.q & 15); vb0 = kr0 * GRID_W + c16; vb1 = vb0 + GRID_W; }
    const GAS bf16* kp = c.Kq + (size_t)ktok * NAW;
#pragma unroll
    for (int d0 = 0; d0 < 4; ++d0) kv.k[d0] = *(const GAS bf16x8*)(kp + d0 * 16);
#pragma unroll
    for (int dh = 0; dh < 2; ++dh)
#pragma unroll
        for (int s = 0; s < 2; ++s) { const GAS bf16* p = c.Vh + (size_t)dh * 32 * MT + (s ? vb1 : vb0);
            kv.v[dh][s][0] = *(const GAS u32x2*)p; kv.v[dh][s][1] = *(const GAS u32x2*)(p + 8); }
}
struct AttState { float mrun, lsum; f32x16 o0, o1; };
__device__ __forceinline__ void att_compute(AttState& st, const AttKV& kv, const bf16x8 (&qf)[4], const LAS float* bh, int b, int r, int rs, int ch, int qc, int cst, int hi) {
    f32x16 S;
#pragma unroll
    for (int i = 0; i < 16; ++i) S[i] = 0.f;
#pragma unroll
    for (int d0 = 0; d0 < 4; ++d0) S = __builtin_amdgcn_mfma_f32_32x32x16_bf16(kv.k[d0], qf[d0], S, 0, 0, 0);
    if (b >= 8) {
        const int wb = b - 8, rp = wb / 3, cc = wb - 3 * rp, kr0 = rs + 2 * rp, c16 = 16 * ch + 16 * cc;
#pragma unroll
        for (int i = 0; i < 16; ++i) {
            const int kj = crow(i, hi), krow = kr0 + (kj >> 4), kc = c16 + (kj & 15);
            int ci = kc - qc + 15; ci = ci < 0 ? 0 : (ci > 30 ? 30 : ci);
            const float bv = bh[(krow - r + 7) * 31 + ci];
            S[i] = (kc >= cst && kc < cst + 16) ? S[i] + bv : -__builtin_inff();
        }
    }
    float bm = S[0];
#pragma unroll
    for (int i = 1; i < 16; ++i) bm = fmaxf(bm, S[i]);
    bm = fmaxf(bm, __shfl_xor(bm, 32));
    const float mn = fmaxf(st.mrun, bm), alpha = __builtin_amdgcn_exp2f(st.mrun - mn);
    st.mrun = mn;
    float ps = 0.f;
#pragma unroll
    for (int i = 0; i < 16; ++i) { S[i] = __builtin_amdgcn_exp2f(S[i] - mn); ps += S[i]; }
    st.lsum = st.lsum * alpha + ps;
#pragma unroll
    for (int i = 0; i < 16; ++i) { st.o0[i] *= alpha; st.o1[i] *= alpha; }
    u32x4 pw0, pw1;
    pw0.x = cvtpk2(S[0], S[1]); pw0.y = cvtpk2(S[2], S[3]); pw0.z = cvtpk2(S[4], S[5]); pw0.w = cvtpk2(S[6], S[7]);
    pw1.x = cvtpk2(S[8], S[9]); pw1.y = cvtpk2(S[10], S[11]); pw1.z = cvtpk2(S[12], S[13]); pw1.w = cvtpk2(S[14], S[15]);
    const bf16x8 pb0 = __builtin_bit_cast(bf16x8, pw0), pb1 = __builtin_bit_cast(bf16x8, pw1);
#define VFRAG(dh, s) __builtin_bit_cast(bf16x8, (u32x4){kv.v[dh][s][0].x, kv.v[dh][s][0].y, kv.v[dh][s][1].x, kv.v[dh][s][1].y})
    st.o0 = __builtin_amdgcn_mfma_f32_32x32x16_bf16(VFRAG(0, 0), pb0, st.o0, 0, 0, 0);
    st.o0 = __builtin_amdgcn_mfma_f32_32x32x16_bf16(VFRAG(0, 1), pb1, st.o0, 0, 0, 0);
    st.o1 = __builtin_amdgcn_mfma_f32_32x32x16_bf16(VFRAG(1, 0), pb0, st.o1, 0, 0, 0);
    st.o1 = __builtin_amdgcn_mfma_f32_32x32x16_bf16(VFRAG(1, 1), pb1, st.o1, 0, 0, 0);
#undef VFRAG
}
__device__ __forceinline__ void att_task(const bf16* Qb, const bf16* Kb, const bf16* Vt, bf16* Ob, const LAS float* bias, int h, int r, int ch, int lane) {
    const int q = lane & 31, hi = lane >> 5, qc = 32 * ch + q, tq = GRID_W * r + qc;
    int rs = r - 4; rs = rs < 0 ? 0 : (rs > 248 ? 248 : rs);
    int cst = qc - 8; cst = cst < 0 ? 0 : (cst > 48 ? 48 : cst);
    AttCtx c; c.Kq = (const GAS bf16*)(Kb + h * HD + 8 * hi); c.Vh = (const GAS bf16*)(Vt + (size_t)(h * HD + q) * MT + 4 * hi); c.rs = rs; c.ch = ch; c.q = q; c.hi = hi;
    AttKV ka, kb, kc;
    att_load(ka, c, 0); att_load(kb, c, 1);
    bf16x8 qf[4];
#pragma unroll
    for (int d0 = 0; d0 < 4; ++d0) qf[d0] = *(const GAS bf16x8*)(Qb + (size_t)tq * NAW + h * HD + d0 * 16 + 8 * hi);
    AttState st; st.mrun = -1e30f; st.lsum = 0.f;
#pragma unroll
    for (int i = 0; i < 16; ++i) { st.o0[i] = 0.f; st.o1[i] = 0.f; }
    const LAS float* bh = bias + h * 465;
    for (int b = 0; b < 18; b += 3) {
        att_load(kc, c, b + 2); att_compute(st, ka, qf, bh, b, r, rs, ch, qc, cst, hi);
        att_load(ka, c, b + 3); att_compute(st, kb, qf, bh, b + 1, r, rs, ch, qc, cst, hi);
        att_load(kb, c, b + 4); att_compute(st, kc, qf, bh, b + 2, r, rs, ch, qc, cst, hi);
    }
    att_compute(st, ka, qf, bh, 18, r, rs, ch, qc, cst, hi);
    att_compute(st, kb, qf, bh, 19, r, rs, ch, qc, cst, hi);
    float lsum = st.lsum + __shfl_xor(st.lsum, 32);
    const float inv = 1.0f / lsum;
    GAS bf16* orow = (GAS bf16*)(Ob + (size_t)tq * D + h * HD);
#pragma unroll
    for (int g4 = 0; g4 < 4; ++g4) {
        u32x2 w0, w1;
        w0.x = cvtpk2(st.o0[4 * g4] * inv, st.o0[4 * g4 + 1] * inv); w0.y = cvtpk2(st.o0[4 * g4 + 2] * inv, st.o0[4 * g4 + 3] * inv);
        w1.x = cvtpk2(st.o1[4 * g4] * inv, st.o1[4 * g4 + 1] * inv); w1.y = cvtpk2(st.o1[4 * g4 + 2] * inv, st.o1[4 * g4 + 3] * inv);
        *(GAS u32x2*)(orow + 8 * g4 + 4 * hi) = w0;
        *(GAS u32x2*)(orow + 32 + 8 * g4 + 4 * hi) = w1;
    }
}
__device__ __forceinline__ void pool_task(const bf16* Ub, bf16* Ob, int t0, int lane) {
    const int g = lane >> 4, hw = 1 << g;
    u32x4 rw[23];
#pragma unroll
    for (int j = 0; j < 23; ++j) { const int t = t0 - 8 + j; rw[j] = (t >= 0 && t < LSEQ) ? *(const GAS u32x4*)(Ub + (size_t)t * NAW + 8 * lane) : (u32x4){0u, 0u, 0u, 0u}; }
#pragma unroll
    for (int i = 0; i < 8; ++i) {
        const int t = t0 + i, ci = i + 8;
        int lo = t - hw; lo = lo < 0 ? 0 : lo; int hi_ = t + hw; hi_ = hi_ > LSEQ ? LSEQ : hi_;
        const float rc = 1.0f / (float)(hi_ - lo);
        u32x4 ow;
#pragma unroll
        for (int d = 0; d < 4; ++d) {
            float sl = 0.f, sh = 0.f, r1l, r1h, r2l, r2h, r4l, r4h;
#define ADDROW(j) do { sl += bf_lo(rw[j][d]); sh += bf_hi(rw[j][d]); } while (0)
            ADDROW(ci - 1); ADDROW(ci); r1l = sl; r1h = sh;
            ADDROW(ci - 2); ADDROW(ci + 1); r2l = sl; r2h = sh;
            ADDROW(ci - 4); ADDROW(ci - 3); ADDROW(ci + 2); ADDROW(ci + 3); r4l = sl; r4h = sh;
            ADDROW(ci - 8); ADDROW(ci - 7); ADDROW(ci - 6); ADDROW(ci - 5); ADDROW(ci + 4); ADDROW(ci + 5); ADDROW(ci + 6); ADDROW(ci + 7);
#undef ADDROW
            const float vl = g == 0 ? r1l : (g == 1 ? r2l : (g == 2 ? r4l : sl)), vh = g == 0 ? r1h : (g == 1 ? r2h : (g == 2 ? r4h : sh));
            ow[d] = cvtpk2(vl * rc - bf_lo(rw[ci][d]), vh * rc - bf_hi(rw[ci][d]));
        }
        *(GAS u32x4*)(Ob + (size_t)t * D + NAW + 8 * lane) = ow;
    }
}
__device__ __forceinline__ void att_phase(Frame& F) {
    LAS float* bias = (LAS float*)(F.lds + RING_OFF);
    for (int i = F.tid; i < NHEADS * 465; i += NWAVES * 64) bias[i] = F.in[11][i] * LOG2E;
    __syncthreads();
    const int gw = F.vcu * NWAVES + F.wave, NGW = F.G * NWAVES;
    const bf16* Qb = (const bf16*)(F.ws + WS_Q); const bf16* Kb = (const bf16*)(F.ws + WS_K); const bf16* Vt = (const bf16*)(F.ws + WS_VT); const bf16* Ub = (const bf16*)(F.ws + WS_U);
    bf16* Ob = (bf16*)(F.ws + WS_ACT);
    for (int T = gw; T < 4096; T += NGW) {
        const int blk = T >> 3, w8 = T & 7, x = (blk & 255) >> 5, bl = (blk & 31) + 32 * (blk >> 8);
        const int h = bl >> 3, rg = bl & 7, r = 32 * x + 4 * rg + (w8 >> 1), ch = w8 & 1;
        att_task(Qb, Kb, Vt, Ob, bias, h, r, ch, F.lane);
    }
    for (int T = gw; T < LSEQ / 8; T += NGW) pool_task(Ub, Ob, 8 * T, F.lane);
    __syncthreads();
}
__device__ __forceinline__ void conv_phase(Frame& F) {
    const int gw = F.vcu * NWAVES + F.wave, NGW = F.G * NWAVES, lane = F.lane;
    const bf16* BG = (const bf16*)(F.ws + WS_BG); const bf16* Z = (const bf16*)(F.ws + WS_Z); bf16* P = (bf16*)(F.ws + WS_ACT);
    const float* cw = F.in[15];
    for (int T = gw; T < LSEQ / 8; T += NGW) {
        const int t0 = 8 * T;
#pragma unroll
        for (int hf = 0; hf < 2; ++hf) {
            const int c0 = 512 * hf + 8 * lane;
            float w[3][8];
#pragma unroll
            for (int k = 0; k < 3; ++k) { const f32x4 a = *(const f32x4*)(cw + k * D + c0), b = *(const f32x4*)(cw + k * D + c0 + 4);
                w[k][0] = a.x; w[k][1] = a.y; w[k][2] = a.z; w[k][3] = a.w; w[k][4] = b.x; w[k][5] = b.y; w[k][6] = b.z; w[k][7] = b.w; }
            u32x4 zr[10];
#pragma unroll
            for (int j = 0; j < 10; ++j) { const int t = t0 - 1 + j; zr[j] = (t >= 0 && t < LSEQ) ? *(const GAS u32x4*)(Z + (size_t)t * D + c0) : (u32x4){0u, 0u, 0u, 0u}; }
#pragma unroll
            for (int i = 0; i < 8; ++i) {
                const u32x4 bg = *(const GAS u32x4*)(BG + (size_t)(t0 + i) * D + c0);
                u32x4 ow;
#pragma unroll
                for (int d = 0; d < 4; ++d) {
                    const float yl = w[0][2 * d] * bf_lo(zr[i][d]) + w[1][2 * d] * bf_lo(zr[i + 1][d]) + w[2][2 * d] * bf_lo(zr[i + 2][d]);
                    const float yh = w[0][2 * d + 1] * bf_hi(zr[i][d]) + w[1][2 * d + 1] * bf_hi(zr[i + 1][d]) + w[2][2 * d + 1] * bf_hi(zr[i + 2][d]);
                    ow[d] = cvtpk2(bf_lo(bg[d]) * yl, bf_hi(bg[d]) * yh);
                }
                *(GAS u32x4*)(P + (size_t)(t0 + i) * D + c0) = ow;
            }
        }
    }
}

struct Args { const float* in[18]; float* out; unsigned char* ws; int ph_lo, ph_hi; };
static_assert(sizeof(Args) == 18 * 8 + 8 + 8 + 8, "Args has no padding");

__device__ __forceinline__ void ffn_up(Frame& F, int widx, int M) {
    pg8::Gemm g{(const bf16*)(F.ws + WS_ACT), (const bf16*)(F.ws + WS_W13T + (size_t)widx * W13T_BYTES), M, 2 * DFF, D};
    pg8::StaticOrder S; S.init(M, 2 * DFF, F.G, (int)blockIdx.x);
    pg8::EpiSwiGLU E{(bf16*)(F.ws + WS_H), DFF};
    pg8::gemm_phase<pg8::EpiSwiGLU, pg8::StaticOrder, true, true>(F.lds + RING_OFF, g, S, E);
}
__device__ __forceinline__ void ffn_down(Frame& F, int widx, int M, const float* base_l, const float* base_c, const float* gate_l, const float* gate_c, float* outp) {
    pg8::Gemm g{(const bf16*)(F.ws + WS_H), (const bf16*)(F.ws + WS_W2T + (size_t)widx * W2T_BYTES), M, D, DFF};
    pg8::StaticOrder S; S.init(M, D, F.G, (int)blockIdx.x);
    pg8::EpiResid E{base_l, base_c, outp, gate_l, gate_c, 0.5f, LSEQ, D};
    pg8::gemm_phase<pg8::EpiResid, pg8::StaticOrder, true, true>(F.lds + RING_OFF, g, S, E);
}
__device__ __forceinline__ void proj_out(Frame& F, size_t wt_off, const float* gate, float* outp) {
    float* xres = (float*)(F.ws + WS_XRES);
    pg8::Gemm g{(const bf16*)(F.ws + WS_ACT), (const bf16*)(F.ws + wt_off), LSEQ, D, D};
    pg8::StaticOrder S; S.init(LSEQ, D, F.G, (int)blockIdx.x);
    pg8::EpiResid E{xres, xres, outp, gate, gate, 1.0f, LSEQ, D};
    pg8::gemm_phase<pg8::EpiResid, pg8::StaticOrder, true, true>(F.lds + RING_OFF, g, S, E);
}

__global__ void __launch_bounds__(NWAVES * 64, 2) mk_fwd(Args args) {
    extern __shared__ __attribute__((aligned(16))) unsigned char lds[];
    Frame F;
    F.lds = (LAS unsigned char*)lds;
    F.MISC = (volatile LAS unsigned*)(F.lds + MISC_OFF);
    F.tid = threadIdx.x; F.lane = F.tid & 63; F.wave = __builtin_amdgcn_readfirstlane(F.tid >> 6);
    F.G = gridDim.x; { const int bx = blockIdx.x; F.vcu = (F.G % 8 == 0) ? (bx % 8) * (F.G / 8) + bx / 8 : bx; }
    F.ws = args.ws; F.out = args.out; F.ctl = (gu32*)(args.ws + WS_CTL);
#pragma unroll
    for (int i = 0; i < 18; ++i) F.in[i] = args.in[i];
    for (int u = F.tid; u < (LDS_BYTES - LDSCTL_OFF) / 4; u += NWAVES * 64) ((LAS unsigned*)(F.lds + LDSCTL_OFF))[u] = 0u;
    __syncthreads();
    const int lo = args.ph_lo, hi = args.ph_hi;
    const bool multi = (hi - lo) > 1;
    XcdBarrier bar; bar.bar = (unsigned*)(F.ctl + CW_BAR); bar.x = 0; bar.st = nullptr;
    if (multi) bar = xcd_barrier_post((unsigned*)(F.ctl + CW_BAR), F.MISC + 8);
#define IN(k) (lo <= (k) && (k) < hi)
#define SEAM(k) do { if (IN(k) && IN((k) + 1)) xcd_barrier(bar); } while (0)
    const float* mv = (const float*)(F.ws + WS_MOD);
    const float* ml0 = mv; const float* mc0 = mv + MODW; const float* ml1 = mv + 2 * MODW;
    float* xres = (float*)(F.ws + WS_XRES);
    bf16* act = (bf16*)(F.ws + WS_ACT);
    const float* ng = F.in[6];

#ifndef PROBE_MASK
#define PROBE_MASK 0u
#endif
#define PH(k, ...) do { if (IN(k)) { if ((PROBE_MASK >> (k)) & 1u) { const bool dup = true; (void)dup; __VA_ARGS__ xcd_barrier(bar); } { const bool dup = false; (void)dup; __VA_ARGS__ } } SEAM(k); } while (0)
    PH(0, { p0_prologue(F); });
    PH(1, { norm_rows_bf16(F, F.in[0], act, LSEQ, ng + 0 * D, ml0 + 0 * D, ml0 + 1 * D);
            norm_rows_bf16(F, F.in[2], act + (size_t)LSEQ * D, NCTX, ng + 0 * D, mc0 + 0 * D, mc0 + 1 * D); });
    PH(2, { ffn_up(F, 0, MT); });
    PH(3, { ffn_down(F, 0, MT, F.in[0], F.in[2], ml0 + 2 * D, mc0 + 2 * D, xres); });
    PH(4, { norm_rows_bf16(F, xres, act, LSEQ, ng + 1 * D, ml0 + 3 * D, ml0 + 4 * D);
            norm_rows_bf16(F, xres + (size_t)LSEQ * D, act + (size_t)LSEQ * D, NCTX, ng + 1 * D, mc0 + 3 * D, mc0 + 4 * D); });
    PH(5, {
        pg8::Gemm g{(const bf16*)act, (const bf16*)(F.ws + WS_WINT), LSEQ, 2048, D};
        pg8::WinOrder S; S.init(LSEQ, 2048, F.G, (int)blockIdx.x);
        pg8::EpiWin E{F.ws + WS_Q, (bf16*)(F.ws + WS_VT), 0.125f * LOG2E, MT, (unsigned)(WS_K - WS_Q), (unsigned)(WS_U - WS_Q)};
        pg8::gemm_phase<pg8::EpiWin, pg8::WinOrder, true, true>(F.lds + RING_OFF, g, S, E);
    });
    PH(6, { att_phase(F); });
    PH(7, { proj_out(F, WS_WOUTT, ml0 + 5 * D, dup ? F.out : xres); });
    PH(8, { norm_rows_bf16(F, xres, act, LSEQ, ng + 2 * D, ml0 + 6 * D, ml0 + 7 * D); });
    PH(9, { ffn_up(F, 1, LSEQ); });
    PH(10, { ffn_down(F, 1, LSEQ, xres, xres, ml0 + 8 * D, ml0 + 8 * D, dup ? F.out : xres); });
    PH(11, { norm_rows_bf16(F, xres, act, LSEQ, ng + 3 * D, ml1 + 0 * D, ml1 + 1 * D); });
    PH(12, { ffn_up(F, 2, LSEQ); });
    PH(13, { ffn_down(F, 2, LSEQ, xres, xres, ml1 + 2 * D, ml1 + 2 * D, dup ? F.out : xres); });
    PH(14, { norm_rows_bf16(F, xres, act, LSEQ, ng + 4 * D, ml1 + 3 * D, ml1 + 4 * D); });
    PH(15, {
        pg8::Gemm g{(const bf16*)act, (const bf16*)(F.ws + WS_CINT), LSEQ, 3 * D, D};
        pg8::StaticOrder S; S.init(LSEQ, 3 * D, F.G, (int)blockIdx.x);
        pg8::EpiCin E{(bf16*)(F.ws + WS_BG), (bf16*)(F.ws + WS_Z)};
        pg8::gemm_phase<pg8::EpiCin, pg8::StaticOrder, true, true>(F.lds + RING_OFF, g, S, E);
    });
    PH(16, { conv_phase(F); });
    PH(17, { proj_out(F, WS_COUTT, ml1 + 5 * D, dup ? F.out : xres); });
    PH(18, { norm_rows_bf16(F, xres, act, LSEQ, ng + 5 * D, ml1 + 6 * D, ml1 + 7 * D); });
    PH(19, { ffn_up(F, 3, LSEQ); });
    PH(20, { ffn_down(F, 3, LSEQ, xres, xres, ml1 + 8 * D, ml1 + 8 * D, dup ? F.out : xres); });
    PH(21, { norm_rows_final(F, xres, F.out, LSEQ, F.in[17]); });
#undef PH
#undef IN
#undef SEAM
}

#ifndef MK_PER_PHASE
#define MK_PER_PHASE 0
#endif
extern "C" void kernel_launch(void* const* d_in, const int* in_sizes, int n_in, void* d_out, int out_size, void* d_ws, size_t ws_size, hipStream_t stream) {
    static int grid = 0;
    if (grid == 0) {
        if (n_in != 18 || in_sizes[0] != LSEQ * D || out_size != LSEQ * D || ws_size < WS_END) { fprintf(stderr, "kernel_launch: shape/workspace mismatch (n_in %d, in0 %d, out %d, ws %zu)\n", n_in, n_in > 0 ? in_sizes[0] : -1, out_size, ws_size); grid = -1; return; }
        int dev = 0, cus = 0;
        if (hipGetDevice(&dev) != hipSuccess || hipDeviceGetAttribute(&cus, hipDeviceAttributeMultiprocessorCount, dev) != hipSuccess) { grid = -1; return; }
        if (hipFuncSetAttribute((const void*)mk_fwd, hipFuncAttributeMaxDynamicSharedMemorySize, LDS_BYTES) != hipSuccess) { fprintf(stderr, "kernel_launch: hipFuncSetAttribute failed\n"); grid = -1; return; }
        (void)hipGetLastError();
        grid = cus;
    }
    if (grid < 0) return;
    if (hipMemsetAsync((char*)d_ws + WS_CTL, 0, CTL_ZERO_BYTES, stream) != hipSuccess) return;
    Args a{};
    for (int i = 0; i < 18; ++i) a.in[i] = (const float*)d_in[i];
    a.out = (float*)d_out; a.ws = (unsigned char*)d_ws;
#if MK_PER_PHASE
    for (int p = 0; p < N_PHASES; ++p) { a.ph_lo = p; a.ph_hi = p + 1; hipLaunchKernelGGL(mk_fwd, dim3(grid), dim3(NWAVES * 64), LDS_BYTES, stream, a); }
#else
    a.ph_lo = 0; a.ph_hi = N_PHASES; hipLaunchKernelGGL(mk_fwd, dim3(grid), dim3(NWAVES * 64), LDS_BYTES, stream, a);
#endif
}
```

```cpp
#include <hip/hip_runtime.h>
#include <cstdio>
#include <cstdint>
#include <cmath>
namespace pg8 {
#define PG8_LAS __attribute__((address_space(3)))
typedef unsigned short bf16_t;
typedef short bf16x8 __attribute__((ext_vector_type(8)));
typedef float f32x4 __attribute__((ext_vector_type(4)));
typedef unsigned u32x4 __attribute__((ext_vector_type(4)));
constexpr int BM = 256, BK = 64, HALF = 128, HTB = HALF * BK * 2  , STAGE_BYTES = 8 * HTB, NXCD = 8, WGM = 8;

__host__ __device__ __forceinline__ int lds_byte(int r, int c) { const int st = (r >> 4) * 2 + (c >> 5), rr = r & 15, cc = c & 31, ob = rr * 64 + cc * 2; return st * 1024 + (ob ^ (((ob >> 9) & 1) << 5)); }
__host__ __device__ __forceinline__ void stage_rc(int b, int& R, int& C) { const int st = b / 1024, sb = b % 1024, swz = sb ^ (((sb >> 9) & 1) << 5); R = (st >> 1) * 16 + swz / 64; C = (st & 1) * 32 + (swz % 64) / 2; }
__host__ __device__ __forceinline__ int perm32(int rho) { const int n = rho >> 4, i = rho & 15; return 8 * (i >> 2) + 4 * n + (i & 3); }

struct Unit { int pm, pn; };
struct Gemm { const bf16_t* A; const bf16_t* Bt; int M, N, K; };

struct StaticOrder {
    int nM, nN, nwg, G, c;
    __host__ __device__ void init(int M, int N, int G_, int c_) { nM = M / BM; nN = N / BM; nwg = nM * nN; G = G_; c = c_; }
    __host__ __device__ bool next(int i, Unit& u) const {
        const long L = (long)i * G + c; if (L >= nwg) return false;
        int wgid = (int)L; { const int q = nwg / NXCD, r = nwg % NXCD, xcd = wgid % NXCD, off = wgid / NXCD; wgid = (xcd < r ? xcd * (q + 1) : r * (q + 1) + (xcd - r) * q) + off; }
        const int nig = WGM * nN, gid = wgid / nig, fm = gid * WGM, gsz = (nM - fm) < WGM ? (nM - fm) : WGM;
        u.pm = fm + ((wgid % nig) % gsz); u.pn = (wgid % nig) / gsz; return true;
    }
    __device__ __forceinline__ void a_ready(const Unit&) const {}
    __device__ __forceinline__ void done(const Unit&) const {}
};

typedef float f32x2 __attribute__((ext_vector_type(2)));
typedef __bf16 bf16x2_t __attribute__((ext_vector_type(2)));
__device__ __forceinline__ unsigned cvtpk(float lo, float hi) { f32x2 v = {lo, hi}; bf16x2_t b = __builtin_convertvector(v, bf16x2_t); return __builtin_bit_cast(unsigned, b); }
__device__ __forceinline__ float silu_f(float a) { return a * __builtin_amdgcn_rcpf(1.0f + __builtin_amdgcn_exp2f(-1.4426950408889634f * a)); }

__device__ __forceinline__ void store_tile_bf16(const f32x4 (&acc)[2][2][4][2], bf16_t* O, int ldc, int row0, int col0, float sc) {
#pragma unroll
    for (int ai = 0; ai < 2; ++ai)
#pragma unroll
        for (int m = 0; m < 4; ++m) { bf16_t* rowp = O + (size_t)(row0 + ai * HALF + m * 16) * ldc + col0;
#pragma unroll
            for (int bj = 0; bj < 2; ++bj) { const f32x4 v0 = acc[ai][bj][m][0] * sc, v1 = acc[ai][bj][m][1] * sc;
                u32x4 w; w.x = cvtpk(v0[0], v0[1]); w.y = cvtpk(v0[2], v0[3]); w.z = cvtpk(v1[0], v1[1]); w.w = cvtpk(v1[2], v1[3]);
                *(u32x4*)(rowp + bj * HALF) = w; } }
}
template <bool SILU> __device__ __forceinline__ void store_tile_prod(const f32x4 (&acc)[2][2][4][2], bf16_t* O, int ldc, int row0, int col0) {
#pragma unroll
    for (int ai = 0; ai < 2; ++ai)
#pragma unroll
        for (int m = 0; m < 4; ++m) { bf16_t* rowp = O + (size_t)(row0 + ai * HALF + m * 16) * ldc + col0;
            f32x4 a0 = acc[ai][0][m][0], a1 = acc[ai][0][m][1]; const f32x4 b0 = acc[ai][1][m][0], b1 = acc[ai][1][m][1];
            if (SILU) {
#pragma unroll
                for (int e = 0; e < 4; ++e) { a0[e] = silu_f(a0[e]); a1[e] = silu_f(a1[e]); } }
            a0 = a0 * b0; a1 = a1 * b1;
            u32x4 w; w.x = cvtpk(a0[0], a0[1]); w.y = cvtpk(a0[2], a0[3]); w.z = cvtpk(a1[0], a1[1]); w.w = cvtpk(a1[2], a1[3]);
            *(u32x4*)rowp = w; }
}
struct EpiSwiGLU {
    static constexpr bool PERM = true, AFTER_DRAIN = false;
    bf16_t* H; int ldh;
    __device__ __forceinline__ void operator()(const f32x4 (&acc)[2][2][4][2], const Unit& u, int wr, int wc, int fr, int fq) const {
        store_tile_prod<true>(acc, H, ldh, u.pm * BM + wr * 64 + fr, u.pn * HALF + wc * 32 + 8 * fq);
    }
};
struct EpiResid {
    static constexpr bool PERM = false, AFTER_DRAIN = false;
    const float* base_l; const float* base_c; float* out; const float* gate_l; const float* gate_c; float coef; int Lrows, ld;
    __device__ __forceinline__ void operator()(const f32x4 (&acc)[2][2][4][2], const Unit& u, int wr, int wc, int fr, int fq) const {
        const bool isc = (u.pm * BM >= Lrows);
        const float* base = isc ? base_c : base_l; const float* gate = isc ? gate_c : gate_l;
        const int row0 = u.pm * BM + wr * 64 + fr, brow0 = isc ? row0 - Lrows : row0, col0 = u.pn * BM + wc * 32 + 4 * fq;
        f32x4 gv[2][2];
#pragma unroll
        for (int bj = 0; bj < 2; ++bj)
#pragma unroll
            for (int n = 0; n < 2; ++n) gv[bj][n] = *(const f32x4*)(gate + col0 + bj * HALF + n * 16) * coef;
#pragma unroll
        for (int ai = 0; ai < 2; ++ai)
#pragma unroll
            for (int m = 0; m < 4; ++m) { const size_t boff = (size_t)(brow0 + ai * HALF + m * 16) * ld + col0, ooff = (size_t)(row0 + ai * HALF + m * 16) * ld + col0;
#pragma unroll
                for (int bj = 0; bj < 2; ++bj)
#pragma unroll
                    for (int n = 0; n < 2; ++n) { const f32x4 b = *(const f32x4*)(base + boff + bj * HALF + n * 16);
                        *(f32x4*)(out + ooff + bj * HALF + n * 16) = b + gv[bj][n] * acc[ai][bj][m][n]; }
                if (m & 1) asm volatile("" ::: "memory"); }
    }
};
struct EpiWin {
    static constexpr bool PERM = true, AFTER_DRAIN = false;
    unsigned char* qbase; bf16_t* Vt; float qscale; int vt_ld; unsigned k_off, u_off;
    __device__ __forceinline__ void operator()(const f32x4 (&acc)[2][2][4][2], const Unit& u, int wr, int wc, int fr, int fq) const {
        const int pn = u.pn, row0 = u.pm * BM + wr * 64 + fr, lc0 = wc * 32 + 8 * fq;
        if (pn == 4 || pn == 5) {
            const int c0 = (pn - 4) * BM + lc0;
#pragma unroll
            for (int ai = 0; ai < 2; ++ai)
#pragma unroll
                for (int m = 0; m < 4; ++m) { const int tok = row0 + ai * HALF + m * 16;
#pragma unroll
                    for (int bj = 0; bj < 2; ++bj)
#pragma unroll
                        for (int n = 0; n < 2; ++n) { const f32x4 v = acc[ai][bj][m][n]; const unsigned w0 = cvtpk(v[0], v[1]), w1 = cvtpk(v[2], v[3]);
                            bf16_t* p = Vt + (size_t)(c0 + bj * HALF + 4 * n) * vt_ld + tok;
                            p[0] = (bf16_t)(w0 & 0xffffu); p[vt_ld] = (bf16_t)(w0 >> 16); p[2 * (size_t)vt_ld] = (bf16_t)(w1 & 0xffffu); p[3 * (size_t)vt_ld] = (bf16_t)(w1 >> 16); } }
        } else {
            const unsigned off = (pn >= 2 ? k_off : 0u) + (pn >= 6 ? u_off - k_off : 0u);
            bf16_t* dst = (bf16_t*)(qbase + off);
            store_tile_bf16(acc, dst, 512, row0, (pn & 1) * BM + lc0, pn < 2 ? qscale : 1.0f);
        }
    }
};
struct EpiCin {
    static constexpr bool PERM = true, AFTER_DRAIN = false;
    bf16_t *BG, *Z;
    __device__ __forceinline__ void operator()(const f32x4 (&acc)[2][2][4][2], const Unit& u, int wr, int wc, int fr, int fq) const {
        const int row0 = u.pm * BM + wr * 64 + fr, lc0 = wc * 32 + 8 * fq;
        if (u.pn < 4) store_tile_bf16(acc, BG, 1024, row0, u.pn * BM + lc0, 1.0f);
        else store_tile_prod<false>(acc, Z, 1024, row0, (u.pn - 4) * HALF + lc0);
    }
};
struct WinOrder : StaticOrder {
    __device__ bool next(int i, Unit& u) const {
        const long Lx = (long)i * G + c;
        if (Lx < nwg) return StaticOrder::next(i, u);
        if (Lx < nwg + 4) { u.pm = nM; u.pn = 2 + (int)(Lx - nwg); return true; }
        return false;
    }
};

template <class Epi, class Sched, bool ALIGN_EPI = false, bool SP2 = false>
__device__ __forceinline__ void gemm_phase(PG8_LAS unsigned char* lds, const Gemm g, const Sched& S, const Epi& E) {
    const int tid = threadIdx.x, wid = __builtin_amdgcn_readfirstlane(tid >> 6), lane = tid & 63, wr = wid >> 2, wc = wid & 3, fr = lane & 15, fq = lane >> 4;
    const int K = g.K, nt = K / BK;
    unsigned voffA[2], voffB[2];
#pragma unroll
    for (int i = 0; i < 2; ++i) { int R, C; stage_rc(tid * 16 + i * 8192, R, C); const int Rb = Epi::PERM ? ((R & ~31) + perm32(R & 31)) : R;
        voffA[i] = (unsigned)(R * K + C) * 2u; voffB[i] = (unsigned)(Rb * K + C) * 2u; }
    const size_t kstep = (size_t)(BK * 2);
    const size_t hstep = (size_t)HALF * K * 2;
    const size_t tstep = 2 * hstep;
    const unsigned ldsw = (unsigned)wid * 1024u;
    const int aoff = lds_byte(wr * 64 + fr, fq * 8), boff = lds_byte(wc * 32 + fr, fq * 8);
#define PG8_SA(b, h) (((b) * 2 + (h)) * HTB)
#define PG8_SB(b, h) ((4 + (b) * 2 + (h)) * HTB)
#define PG8_STAGE(bufoff, gbase, voff) do { _Pragma("unroll") for (int _i = 0; _i < 2; ++_i) \
        __builtin_amdgcn_global_load_lds((const unsigned*)((const char*)(gbase) + (voff)[_i]), (PG8_LAS unsigned*)(lds + (bufoff) + ldsw + _i * 8192), 16, 0, 0); } while (0)
#define PG8_LDA(dst, b, h) do { _Pragma("unroll") for (int m = 0; m < 4; ++m) _Pragma("unroll") for (int k = 0; k < 2; ++k) dst[m][k] = *(const PG8_LAS bf16x8*)(lds + PG8_SA(b, h) + aoff + m * 2048 + k * 1024); } while (0)
#define PG8_LDB(dst, b, h) do { _Pragma("unroll") for (int n = 0; n < 2; ++n) _Pragma("unroll") for (int k = 0; k < 2; ++k) dst[n][k] = *(const PG8_LAS bf16x8*)(lds + PG8_SB(b, h) + boff + n * 2048 + k * 1024); } while (0)
#define PG8_MMA(ai, bj, At, Bt) do { __builtin_amdgcn_s_setprio(1); _Pragma("unroll") for (int m = 0; m < 4; ++m) _Pragma("unroll") for (int n = 0; n < 2; ++n) _Pragma("unroll") for (int k = 0; k < 2; ++k) \
        acc[ai][bj][m][n] = __builtin_amdgcn_mfma_f32_16x16x32_bf16(Bt[n][k], At[m][k], acc[ai][bj][m][n], 0, 0, 0); __builtin_amdgcn_s_setprio(0); } while (0)
#define PG8_WAIT_V(n) asm volatile("s_waitcnt vmcnt(" #n ")" ::: "memory")
#define PG8_WAIT_L(n) asm volatile("s_waitcnt lgkmcnt(" #n ")" ::: "memory")
#define PG8_BAR __builtin_amdgcn_s_barrier()
#define PG8_SCHED __builtin_amdgcn_sched_barrier(0)
    Unit cur, nxt; int ui = 0;
    if (!S.next(0, cur)) return;
    f32x4 acc[2][2][4][2];
#pragma unroll
    for (int a = 0; a < 2; ++a)
#pragma unroll
        for (int b = 0; b < 2; ++b)
#pragma unroll
            for (int m = 0; m < 4; ++m)
#pragma unroll
                for (int n = 0; n < 2; ++n) acc[a][b][m][n] = (f32x4){0.f, 0.f, 0.f, 0.f};
    bf16x8 At[4][2], B0[2][2], B1[2][2];
    const char* cA = (const char*)g.A + (size_t)cur.pm * tstep; const char* cB = (const char*)g.Bt + (size_t)cur.pn * tstep;
    S.a_ready(cur);
    if constexpr (SP2) {
        PG8_STAGE(PG8_SB(0, 0), cB, voffB); PG8_STAGE(PG8_SB(0, 1), cB + hstep, voffB); PG8_STAGE(PG8_SA(0, 0), cA, voffA); PG8_STAGE(PG8_SA(0, 1), cA + hstep, voffA);
        if (wr == 1) PG8_BAR;
        PG8_WAIT_V(2); PG8_BAR;
        PG8_STAGE(PG8_SB(1, 0), cB + kstep, voffB); PG8_STAGE(PG8_SA(1, 0), cA + kstep, voffA); PG8_STAGE(PG8_SB(1, 1), cB + hstep + kstep, voffB);
        PG8_WAIT_V(6); PG8_BAR;
    } else {
        PG8_STAGE(PG8_SB(0, 0), cB, voffB); PG8_STAGE(PG8_SA(0, 0), cA, voffA); PG8_STAGE(PG8_SB(0, 1), cB + hstep, voffB); PG8_STAGE(PG8_SA(0, 1), cA + hstep, voffA);
        if (wr == 1) PG8_BAR;
        PG8_WAIT_V(4); PG8_BAR;
        PG8_STAGE(PG8_SB(1, 0), cB + kstep, voffB); PG8_STAGE(PG8_SA(1, 0), cA + kstep, voffA); PG8_STAGE(PG8_SB(1, 1), cB + hstep + kstep, voffB);
        PG8_WAIT_V(6); PG8_BAR;
    }
    for (;;) {
        const bool has_next = S.next(ui + 1, nxt);
        const char* nA = has_next ? (const char*)g.A + (size_t)nxt.pm * tstep : cA; const char* nB = has_next ? (const char*)g.Bt + (size_t)nxt.pn * tstep : cB;
        for (int t = 0; t < nt; t += 2) {
            const bool last = (t == nt - 2);
            const char* a1 = cA + (size_t)(t + 1) * kstep;
            const char* a2 = last ? nA : cA + (size_t)(t + 2) * kstep; const char* b2 = last ? nB : cB + (size_t)(t + 2) * kstep;
            const char* a3 = a2 + kstep; const char* b3 = b2 + kstep;
            if (last && has_next) S.a_ready(nxt);
            if constexpr (SP2) {
            PG8_LDB(B0, 0, 0); PG8_LDB(B1, 0, 1); PG8_SCHED; PG8_LDA(At, 0, 0); PG8_STAGE(PG8_SA(1, 1), a1 + hstep, voffA);
            PG8_WAIT_V(8); PG8_WAIT_L(0); PG8_BAR; PG8_MMA(0, 0, At, B0); PG8_MMA(0, 1, At, B1); PG8_BAR; PG8_SCHED;
            PG8_LDA(At, 0, 1); PG8_STAGE(PG8_SB(0, 0), b2, voffB); PG8_STAGE(PG8_SB(0, 1), b2 + hstep, voffB); PG8_STAGE(PG8_SA(0, 0), a2, voffA);
            PG8_WAIT_V(8); PG8_WAIT_L(0); PG8_BAR; PG8_MMA(1, 0, At, B0); PG8_MMA(1, 1, At, B1); PG8_BAR; PG8_SCHED;
            PG8_LDB(B0, 1, 0); PG8_LDB(B1, 1, 1); PG8_SCHED; PG8_LDA(At, 1, 0); PG8_STAGE(PG8_SA(0, 1), a2 + hstep, voffA);
            PG8_WAIT_V(8); PG8_WAIT_L(0); PG8_BAR; PG8_MMA(0, 0, At, B0); PG8_MMA(0, 1, At, B1); PG8_BAR; PG8_SCHED;
            PG8_LDA(At, 1, 1); PG8_STAGE(PG8_SB(1, 0), b3, voffB); PG8_STAGE(PG8_SB(1, 1), b3 + hstep, voffB); PG8_STAGE(PG8_SA(1, 0), a3, voffA);
            PG8_WAIT_V(8); PG8_WAIT_L(0); PG8_BAR; PG8_MMA(1, 0, At, B0); PG8_MMA(1, 1, At, B1); PG8_BAR; PG8_SCHED;
            } else {
            PG8_LDB(B0, 0, 0); PG8_SCHED; PG8_LDA(At, 0, 0); PG8_STAGE(PG8_SA(1, 1), a1 + hstep, voffA);
            PG8_WAIT_L(8); PG8_BAR; PG8_WAIT_L(0); PG8_MMA(0, 0, At, B0); PG8_BAR; PG8_SCHED;
            PG8_LDB(B1, 0, 1); PG8_STAGE(PG8_SB(0, 0), b2, voffB);
            PG8_BAR; PG8_WAIT_L(0); PG8_MMA(0, 1, At, B1); PG8_BAR;
            PG8_LDA(At, 0, 1); PG8_STAGE(PG8_SA(0, 0), a2, voffA);
            PG8_BAR; PG8_WAIT_L(0); PG8_MMA(1, 0, At, B0); PG8_BAR; PG8_SCHED;
            PG8_STAGE(PG8_SB(0, 1), b2 + hstep, voffB);
            PG8_WAIT_V(6); PG8_BAR; PG8_MMA(1, 1, At, B1); PG8_BAR;
            PG8_LDB(B0, 1, 0); PG8_SCHED; PG8_LDA(At, 1, 0); PG8_STAGE(PG8_SA(0, 1), a2 + hstep, voffA);
            PG8_WAIT_L(8); PG8_BAR; PG8_WAIT_L(0); PG8_MMA(0, 0, At, B0); PG8_BAR; PG8_SCHED;
            PG8_LDB(B1, 1, 1); PG8_STAGE(PG8_SB(1, 0), b3, voffB);
            PG8_BAR; PG8_WAIT_L(0); PG8_MMA(0, 1, At, B1); PG8_BAR;
            PG8_LDA(At, 1, 1); PG8_STAGE(PG8_SA(1, 0), a3, voffA);
            PG8_BAR; PG8_WAIT_L(0); PG8_MMA(1, 0, At, B0); PG8_BAR; PG8_SCHED;
            PG8_STAGE(PG8_SB(1, 1), b3 + hstep, voffB);
            PG8_WAIT_V(6); PG8_BAR; PG8_MMA(1, 1, At, B1); PG8_BAR;
            }
        }
        if constexpr (ALIGN_EPI) { if (wr == 0) PG8_BAR; }
        if constexpr (!Epi::AFTER_DRAIN) { E(acc, cur, wr, wc, fr, fq); S.done(cur); }
        if (!has_next) break;
#pragma unroll
        for (int a = 0; a < 2; ++a)
#pragma unroll
            for (int b = 0; b < 2; ++b)
#pragma unroll
                for (int m = 0; m < 4; ++m)
#pragma unroll
                    for (int n = 0; n < 2; ++n) acc[a][b][m][n] = (f32x4){0.f, 0.f, 0.f, 0.f};
        cur = nxt; cA = nA; cB = nB; ++ui;
        if constexpr (ALIGN_EPI) { if (wr == 1) PG8_BAR; }
    }
    PG8_WAIT_V(0);
    if constexpr (!ALIGN_EPI) { if (wr == 0) PG8_BAR; }
    PG8_BAR;
    if constexpr (Epi::AFTER_DRAIN) { E.fused(acc, cur, wr, wc, fr, fq, lds, wid, lane); S.done(cur); }
#undef PG8_SA
#undef PG8_SB
#undef PG8_STAGE
#undef PG8_LDA
#undef PG8_LDB
#undef PG8_MMA
#undef PG8_WAIT_V
#undef PG8_WAIT_L
#undef PG8_BAR
#undef PG8_SCHED
}
}
#define GAS __attribute__((address_space(1)))
#define LAS __attribute__((address_space(3)))
typedef unsigned short bf16;
typedef unsigned v4u __attribute__((ext_vector_type(4)));
typedef float f32x4 __attribute__((ext_vector_type(4)));
typedef short bf16x8 __attribute__((ext_vector_type(8)));
typedef GAS unsigned gu32;
typedef GAS unsigned long long gu64;
#define RLX_AGENT __ATOMIC_RELAXED, __HIP_MEMORY_SCOPE_AGENT
#define LDS_WAIT() asm volatile("s_waitcnt lgkmcnt(0)" ::: "memory")
#define VM_WAIT() asm volatile("s_waitcnt vmcnt(0)" ::: "memory")
__device__ __forceinline__ unsigned long long rt() { return __builtin_amdgcn_s_memrealtime(); }
__device__ __forceinline__ unsigned f2bf(float f) { unsigned u = __builtin_bit_cast(unsigned, f); return (u + 0x7fffu + ((u >> 16) & 1u)) >> 16; }
__device__ __forceinline__ unsigned pk2(float lo, float hi) { return f2bf(lo) | (f2bf(hi) << 16); }

#define XB_TMO      128
#define XB_XCNT(j)  (256  + 64 * (j))
#define XB_XSUB(j)  (1280 + 64 * (j))
#define XB_XGEN(j)  (2304 + 64 * (j))
#define XB_TOP      3328
#define XB_TOPGEN   3392
#define XCD_BAR_WORDS 3456
#define XB_SPIN_CAP (1u << 18)

__device__ __forceinline__ unsigned xb_ld(unsigned* p)              { return __hip_atomic_load(p, __ATOMIC_RELAXED, __HIP_MEMORY_SCOPE_AGENT); }
__device__ __forceinline__ unsigned xb_add(unsigned* p, unsigned v) { return __hip_atomic_fetch_add(p, v, __ATOMIC_RELAXED, __HIP_MEMORY_SCOPE_AGENT); }
__device__ __forceinline__ unsigned xb_xcc_id() { return (unsigned)__builtin_amdgcn_s_getreg((3 << 11) | 20) & 0xFu; }
#define XB_SPIN(cond, bar) do { unsigned _sp = 0; while (cond) { __builtin_amdgcn_s_sleep(1); \
    if ((++_sp & 255u) == 0u) { if (xb_ld(&(bar)[XB_TMO])) break; if (_sp > XB_SPIN_CAP) { atomicAdd(&(bar)[XB_TMO], 1u); break; } } } } while (0)

struct XcdBarrier {
    unsigned* bar; unsigned x;
    volatile LAS unsigned* st;
};

__device__ __forceinline__ XcdBarrier xcd_barrier_post(unsigned* bar, volatile LAS unsigned* st) {
    XcdBarrier b; b.bar = bar; b.x = xb_xcc_id(); b.st = st;
    if (threadIdx.x == 0) (void)xb_add(&bar[XB_XCNT(b.x)], 1u);
    return b;
}
__device__ __forceinline__ void xcd_barrier_complete(unsigned* bar, unsigned x, unsigned& nloc, unsigned& nx) {
    const unsigned G = gridDim.x * gridDim.y * gridDim.z;
    unsigned sum, cnt, mine, sp = 0u;
    for (;;) {
        sum = 0u; cnt = 0u; mine = 0u;
#pragma unroll
        for (unsigned j = 0; j < 16; ++j) { const unsigned c = xb_ld(&bar[XB_XCNT(j)]); sum += c; cnt += (c > 0u) ? 1u : 0u; mine = (j == x) ? c : mine; }
        if (sum == G) break;
        __builtin_amdgcn_s_sleep(1);
        if ((++sp & 255u) == 0u) { if (xb_ld(&bar[XB_TMO])) break; if (sp > XB_SPIN_CAP) { atomicAdd(&bar[XB_TMO], 1u); break; } }
    }
    nloc = mine > 0u ? mine : 1u; nx = cnt > 0u ? cnt : 1u;
}

__device__ __forceinline__ void xcd_barrier(const XcdBarrier& b) {
    asm volatile("s_waitcnt vmcnt(0)" ::: "memory");
    __syncthreads();
    if (threadIdx.x == 0) {
        unsigned* bar = b.bar;
        __builtin_amdgcn_s_waitcnt(0);
        unsigned nloc = b.st[0], nx = b.st[1];
        if (nloc == 0u) { xcd_barrier_complete(bar, b.x, nloc, nx); b.st[0] = nloc; b.st[1] = nx; }
        const unsigned old = xb_add(&bar[XB_XSUB(b.x)], 1u);
        const unsigned gen = old / nloc;
        if (old + 1u == (gen + 1u) * nloc) {
            __builtin_amdgcn_fence(__ATOMIC_RELEASE, "agent");
            asm volatile("s_waitcnt vmcnt(0)" ::: "memory");
            const unsigned og = xb_add(&bar[XB_TOP], 1u);
            const unsigned tg = og / nx;
            if (og + 1u == (tg + 1u) * nx) xb_add(&bar[XB_TOPGEN], 1u);
            else XB_SPIN(xb_ld(&bar[XB_TOPGEN]) == tg, bar);
            __builtin_amdgcn_fence(__ATOMIC_ACQUIRE, "agent");
            xb_add(&bar[XB_XGEN(b.x)], 1u);
            asm volatile("s_waitcnt vmcnt(0)" ::: "memory");
        } else {
            XB_SPIN(xb_ld(&bar[XB_XGEN(b.x)]) == gen, bar);
            __builtin_amdgcn_fence(__ATOMIC_ACQUIRE, "agent");
            asm volatile("s_waitcnt vmcnt(0)" ::: "memory");
        }
    }
    __syncthreads();
}
typedef unsigned u32x4 __attribute__((ext_vector_type(4)));
__device__ __forceinline__ unsigned cvtpk2(float lo, float hi) { return pg8::cvtpk(lo, hi); }

constexpr int NWAVES = 8;
constexpr int D = 1024, LSEQ = 16384, NCTX = 256, MT = LSEQ + NCTX, DFF = 2816, NMOD = 9, MODW = NMOD * D;
constexpr int GRID_W = 64, NHEADS = 8, HD = 64, NAW = 512;
constexpr float RMS_EPS = 1e-6f, LOG2E = 1.4426950408889634f;
constexpr int N_PHASES = 22;

constexpr size_t MiB = 1u << 20;
constexpr size_t WS_CTL = 0, CTL_ZERO_BYTES = 1 * MiB;
constexpr size_t WS_MOD = 1 * MiB;
constexpr size_t WS_W13T = 2 * MiB, W13T_BYTES = (size_t)2 * DFF * D * 2;
constexpr size_t WS_W2T = 46 * MiB, W2T_BYTES = (size_t)D * DFF * 2;
constexpr size_t WS_WINT = 68 * MiB, WS_WOUTT = 72 * MiB, WS_CINT = 74 * MiB, WS_COUTT = 80 * MiB;
constexpr size_t WS_XRES = 82 * MiB;
constexpr size_t WS_ACT = 147 * MiB;
constexpr size_t WS_H = 180 * MiB;
constexpr size_t WS_Q = 180 * MiB, WS_K = 196 * MiB, WS_VT = 213 * MiB, WS_U = 230 * MiB;
constexpr size_t WS_BG = 180 * MiB, WS_Z = 212 * MiB;
constexpr size_t WS_END = 270 * MiB;
static_assert(WS_W13T + 4 * W13T_BYTES <= WS_W2T && WS_W2T + 4 * W2T_BYTES <= WS_WINT && WS_XRES + (size_t)MT * D * 4 <= WS_ACT && WS_ACT + (size_t)MT * D * 2 <= WS_H && WS_H + (size_t)MT * DFF * 2 <= WS_END, "d_ws map");
static_assert(WS_K + (size_t)MT * 512 * 2 <= WS_VT && WS_VT + (size_t)MT * 512 * 2 <= WS_U && WS_U + (size_t)LSEQ * 512 * 2 <= WS_END, "mixer overlay map");
constexpr int CW_BAR = 4096;

constexpr int RING_OFF = 0, RING_BYTES = 131072;
constexpr int LDSCTL_OFF = RING_BYTES, MISC_OFF = LDSCTL_OFF + 320;
constexpr int STAB_OFF = RING_BYTES + 1024;
constexpr int LDS_BYTES = 147456;
static_assert(STAB_OFF + 8192 <= LDS_BYTES, "LDS map");

struct Frame {
    LAS unsigned char* lds;
    volatile LAS unsigned* MISC;
    gu32* ctl;
    int tid, lane, wave, vcu, G;
    const float* in[18];
    float* out; unsigned char* ws;
};
__device__ __forceinline__ float wave_sum(float v) {
#pragma unroll
    for (int o = 1; o < 64; o <<= 1) v += __shfl_xor(v, o);
    return v;
}

__device__ __forceinline__ void p0_transpose_item(const float* W, int K, int ldn, bf16* WT, int k0, int n0, int drow0, LAS float* scr, int lane) {
    { const int nq = lane & 7, kk0 = lane >> 3;
        const GAS float* src = (const GAS float*)(W + (size_t)(k0 + kk0) * ldn + n0 + 4 * nq);
        f32x4 v[8];
#pragma unroll
        for (int i = 0; i < 8; ++i) v[i] = *(const GAS f32x4*)(src + (size_t)(8 * i) * ldn);
#pragma unroll
        for (int i = 0; i < 8; ++i) { LAS float* d = scr + (kk0 + 8 * i) * 33 + 4 * nq; d[0] = v[i].x; d[1] = v[i].y; d[2] = v[i].z; d[3] = v[i].w; }
    }
    LDS_WAIT(); asm volatile("" ::: "memory");
    const int c = lane & 7;
#pragma unroll
    for (int j = 0; j < 4; ++j) { const int n = (lane >> 3) + 8 * j; const LAS float* s = scr + (8 * c) * 33 + n;
        v4u o; o.x = pk2(s[0 * 33], s[1 * 33]); o.y = pk2(s[2 * 33], s[3 * 33]); o.z = pk2(s[4 * 33], s[5 * 33]); o.w = pk2(s[6 * 33], s[7 * 33]);
        *(GAS v4u*)(WT + (size_t)(drow0 + n) * K + k0 + 8 * c) = o; }
    LDS_WAIT(); asm volatile("" ::: "memory");
}
__device__ __forceinline__ int map_swiglu(int n0) { const int half = n0 / DFF, hx = n0 % DFF; return 256 * (hx / 128) + 128 * half + (hx % 128); }
__device__ __forceinline__ int map_cin(int n0) { if (n0 < D) return n0; const int part = (n0 - D) / D, ch = (n0 - D) % D; return D + 256 * (ch / 128) + 128 * part + (ch % 128); }

__device__ __forceinline__ void p0_prologue(Frame& F) {
    LAS float* scr = (LAS float*)(F.lds + RING_OFF + F.wave * 16384);
    LAS float* stab = (LAS float*)(F.lds + STAB_OFF);
    const int gw = F.vcu * NWAVES + F.wave, NGW = F.G * NWAVES, lane = F.lane;
    for (int k = F.tid; k < D; k += NWAVES * 64) { const float a = F.in[1][k], b = F.in[3][k]; stab[k] = a / (1.0f + expf(-a)); stab[D + k] = b / (1.0f + expf(-b)); }
    __syncthreads();
    {
        float* mv = (float*)(F.ws + WS_MOD);
        constexpr int NCH = MODW / 16;
        for (int it = gw; it < 2 * NCH; it += NGW) {
            const int layer = it / NCH, col0 = (it % NCH) * 16, cq = lane & 3, kr = lane >> 2;
            const GAS float* W = (const GAS float*)(F.in[4] + (size_t)layer * D * MODW + col0 + 4 * cq);
            f32x4 al = {0.f, 0.f, 0.f, 0.f}, ac = {0.f, 0.f, 0.f, 0.f};
#pragma unroll 8
            for (int i = 0; i < 64; ++i) { const int k = kr + 16 * i; const f32x4 w = *(const GAS f32x4*)(W + (size_t)k * MODW); al += w * stab[k]; ac += w * stab[D + k]; }
#pragma unroll
            for (int e = 0; e < 4; ++e) {
#pragma unroll
                for (int o = 4; o < 64; o <<= 1) { al[e] += __shfl_xor(al[e], o); ac[e] += __shfl_xor(ac[e], o); } }
            if (lane < 4) {
                const f32x4 b = *(const f32x4*)(F.in[5] + (size_t)layer * MODW + col0 + 4 * cq);
                if (layer == 0) { *(f32x4*)(mv + col0 + 4 * cq) = al + b; *(f32x4*)(mv + MODW + col0 + 4 * cq) = ac + b; }
                else *(f32x4*)(mv + 2 * MODW + col0 + 4 * cq) = al + b;
            }
        }
    }
    if (F.wave == 0) {
        bf16* WINt = (bf16*)(F.ws + WS_WINT);
        for (int it = F.vcu; it < 4 * 64; it += F.G) {
            const int g = it >> 6, k0 = (it & 63) * 16;
#pragma unroll
            for (int i = 0; i < 32; ++i) { const int e = i * 64 + lane, kk = e >> 7, j = e & 127; scr[e] = F.in[9][(size_t)(k0 + kk) * 2048 + 1536 + g * 128 + j]; }
            LDS_WAIT(); asm volatile("" ::: "memory");
            float a0[16], a1[16];
#pragma unroll
            for (int kk = 0; kk < 16; ++kk) { a0[kk] = 0.f; a1[kk] = 0.f; }
            const GAS float* P = (const GAS float*)(F.in[12] + (size_t)g * 128 * 128);
            for (int jc = 0; jc < 128; jc += 16) {
                float p0[16], p1[16];
#pragma unroll
                for (int jj = 0; jj < 16; ++jj) { p0[jj] = P[(jc + jj) * 128 + lane]; p1[jj] = P[(jc + jj) * 128 + 64 + lane]; }
#pragma unroll
                for (int jj = 0; jj < 16; ++jj) {
#pragma unroll
                    for (int kk = 0; kk < 16; ++kk) { const float a = scr[kk * 128 + jc + jj]; a0[kk] += a * p0[jj]; a1[kk] += a * p1[jj]; } }
            }
            const float s0 = F.in[13][g * 128 + lane], s1 = F.in[13][g * 128 + 64 + lane];
            v4u o0, o1, o2, o3;
            o0.x = pk2(a0[0] * s0, a0[1] * s0); o0.y = pk2(a0[2] * s0, a0[3] * s0); o0.z = pk2(a0[4] * s0, a0[5] * s0); o0.w = pk2(a0[6] * s0, a0[7] * s0);
            o1.x = pk2(a0[8] * s0, a0[9] * s0); o1.y = pk2(a0[10] * s0, a0[11] * s0); o1.z = pk2(a0[12] * s0, a0[13] * s0); o1.w = pk2(a0[14] * s0, a0[15] * s0);
            o2.x = pk2(a1[0] * s1, a1[1] * s1); o2.y = pk2(a1[2] * s1, a1[3] * s1); o2.z = pk2(a1[4] * s1, a1[5] * s1); o2.w = pk2(a1[6] * s1, a1[7] * s1);
            o3.x = pk2(a1[8] * s1, a1[9] * s1); o3.y = pk2(a1[10] * s1, a1[11] * s1); o3.z = pk2(a1[12] * s1, a1[13] * s1); o3.w = pk2(a1[14] * s1, a1[15] * s1);
            GAS v4u* d0 = (GAS v4u*)(WINt + (size_t)(1536 + g * 128 + lane) * D + k0);
            GAS v4u* d1 = (GAS v4u*)(WINt + (size_t)(1536 + g * 128 + 64 + lane) * D + k0);
            d0[0] = o0; d0[1] = o1; d1[0] = o2; d1[1] = o3;
            LDS_WAIT(); asm volatile("" ::: "memory");
        }
    }
    {
        constexpr int I_13 = (D / 64) * (2 * DFF / 32), I_2 = (DFF / 64) * (D / 32), I_IN = (D / 64) * (1536 / 32), I_SQ = (D / 64) * (D / 32), I_CI = (D / 64) * (3 * D / 32);
        constexpr int NITEMS = 4 * I_13 + 4 * I_2 + I_IN + I_SQ + I_CI + I_SQ;
        for (int it = gw; it < NITEMS; it += NGW) {
            int r = it;
            if (r < 4 * I_13) { const int mi = r / I_13, q = r % I_13, nblk = 2 * DFF / 32, kb = q / nblk, nb = q % nblk;
                p0_transpose_item(F.in[7] + (size_t)mi * D * 2 * DFF, D, 2 * DFF, (bf16*)(F.ws + WS_W13T + mi * W13T_BYTES), 64 * kb, 32 * nb, map_swiglu(32 * nb), scr, lane); continue; } r -= 4 * I_13;
            if (r < 4 * I_2) { const int mi = r / I_2, q = r % I_2, nblk = D / 32, kb = q / nblk, nb = q % nblk;
                p0_transpose_item(F.in[8] + (size_t)mi * DFF * D, DFF, D, (bf16*)(F.ws + WS_W2T + mi * W2T_BYTES), 64 * kb, 32 * nb, 32 * nb, scr, lane); continue; } r -= 4 * I_2;
            if (r < I_IN) { const int nblk = 1536 / 32, kb = r / nblk, nb = r % nblk;
                p0_transpose_item(F.in[9], D, 2048, (bf16*)(F.ws + WS_WINT), 64 * kb, 32 * nb, 32 * nb, scr, lane); continue; } r -= I_IN;
            if (r < I_SQ) { const int nblk = D / 32, kb = r / nblk, nb = r % nblk;
                p0_transpose_item(F.in[10], D, D, (bf16*)(F.ws + WS_WOUTT), 64 * kb, 32 * nb, 32 * nb, scr, lane); continue; } r -= I_SQ;
            if (r < I_CI) { const int nblk = 3 * D / 32, kb = r / nblk, nb = r % nblk;
                p0_transpose_item(F.in[14], D, 3 * D, (bf16*)(F.ws + WS_CINT), 64 * kb, 32 * nb, map_cin(32 * nb), scr, lane); continue; } r -= I_CI;
            { const int nblk = D / 32, kb = r / nblk, nb = r % nblk;
                p0_transpose_item(F.in[16], D, D, (bf16*)(F.ws + WS_COUTT), 64 * kb, 32 * nb, 32 * nb, scr, lane); }
        }
    }
}

__device__ __forceinline__ void norm_rows_bf16(Frame& F, const float* src, bf16* dst, int nrows, const float* g, const float* shift, const float* scale) {
    const int gw = F.vcu * NWAVES + F.wave, NGW = F.G * NWAVES, lane = F.lane;
    f32x4 A[4], B[4];
#pragma unroll
    for (int j = 0; j < 4; ++j) { const int c = 4 * lane + 256 * j; const f32x4 gv = *(const f32x4*)(g + c), sc = *(const f32x4*)(scale + c); A[j] = gv * (sc + 1.0f); B[j] = *(const f32x4*)(shift + c); }
    for (int m = gw; m < nrows; m += NGW) {
        const GAS f32x4* xr = (const GAS f32x4*)(src + (size_t)m * D) + lane;
        f32x4 v[4]; float s2 = 0.f;
#pragma unroll
        for (int j = 0; j < 4; ++j) { v[j] = xr[64 * j]; s2 += (v[j].x * v[j].x + v[j].y * v[j].y) + (v[j].z * v[j].z + v[j].w * v[j].w); }
        const float rstd = 1.0f / sqrtf(wave_sum(s2) * (1.0f / D) + RMS_EPS);
        GAS unsigned long long* o8 = (GAS unsigned long long*)(dst + (size_t)m * D) + lane;
#pragma unroll
        for (int j = 0; j < 4; ++j) { const f32x4 y = v[j] * rstd * A[j] + B[j]; o8[64 * j] = (unsigned long long)pk2(y.x, y.y) | ((unsigned long long)pk2(y.z, y.w) << 32); }
    }
}
__device__ __forceinline__ void norm_rows_final(Frame& F, const float* src, float* dst, int nrows, const float* g) {
    const int gw = F.vcu * NWAVES + F.wave, NGW = F.G * NWAVES, lane = F.lane;
    f32x4 A[4];
#pragma unroll
    for (int j = 0; j < 4; ++j) A[j] = *(const f32x4*)(g + 4 * lane + 256 * j);
    for (int m = gw; m < nrows; m += NGW) {
        const GAS f32x4* xr = (const GAS f32x4*)(src + (size_t)m * D) + lane;
        f32x4 v[4]; float s2 = 0.f;
#pragma unroll
        for (int j = 0; j < 4; ++j) { v[j] = xr[64 * j]; s2 += (v[j].x * v[j].x + v[j].y * v[j].y) + (v[j].z * v[j].z + v[j].w * v[j].w); }
        const float rstd = 1.0f / sqrtf(wave_sum(s2) * (1.0f / D) + RMS_EPS);
        GAS f32x4* o = (GAS f32x4*)(dst + (size_t)m * D) + lane;
#pragma unroll
        for (int j = 0; j < 4; ++j) o[64 * j] = v[j] * rstd * A[j];
    }
}

typedef float f32x16 __attribute__((ext_vector_type(16)));
typedef unsigned u32x2 __attribute__((ext_vector_type(2)));
__device__ __forceinline__ int crow(int r, int hi) { return (r & 3) + 8 * (r >> 2) + 4 * hi; }
__device__ __forceinline__ float bf_lo(unsigned w) { return __uint_as_float(w << 16); }
__device__ __forceinline__ float bf_hi(unsigned w) { return __uint_as_float(w & 0xffff0000u); }

struct AttKV { bf16x8 k[4]; u32x2 v[2][2][2]; };
struct AttCtx { const GAS bf16* Kq; const GAS bf16* Vh; int rs, ch, q, hi; };
__device__ __forceinline__ void att_load(AttKV& kv, const AttCtx& c, int b) {
    int ktok, vb0, vb1;
    if (b < 8) { const int tok0 = LSEQ + 32 * b; ktok = tok0 + c.q; vb0 = tok0; vb1 = tok0 + 16; }
    else { const int wb = b - 8, rp = wb / 3, cc = wb - 3 * rp, kr0 = c.rs + 2 * rp, c16 = 16 * c.ch + 16 * cc; ktok = (kr0 + (c.q >> 4)) * GRID_W + c16 + (c.q & 15); vb0 = kr0 * GRID_W + c16; vb1 = vb0 + GRID_W; }
    const GAS bf16* kp = c.Kq + (size_t)ktok * NAW;
#pragma unroll
    for (int d0 = 0; d0 < 4; ++d0) kv.k[d0] = *(const GAS bf16x8*)(kp + d0 * 16);
#pragma unroll
    for (int dh = 0; dh < 2; ++dh)
#pragma unroll
        for (int s = 0; s < 2; ++s) { const GAS bf16* p = c.Vh + (size_t)dh * 32 * MT + (s ? vb1 : vb0);
            kv.v[dh][s][0] = *(const GAS u32x2*)p; kv.v[dh][s][1] = *(const GAS u32x2*)(p + 8); }
}
struct AttState { float mrun, lsum; f32x16 o0, o1; };
__device__ __forceinline__ void att_compute(AttState& st, const AttKV& kv, const bf16x8 (&qf)[4], const LAS float* bh, int b, int r, int rs, int ch, int qc, int cst, int hi) {
    f32x16 S;
#pragma unroll
    for (int i = 0; i < 16; ++i) S[i] = 0.f;
#pragma unroll
    for (int d0 = 0; d0 < 4; ++d0) S = __builtin_amdgcn_mfma_f32_32x32x16_bf16(kv.k[d0], qf[d0], S, 0, 0, 0);
    if (b >= 8) {
        const int wb = b - 8, rp = wb / 3, cc = wb - 3 * rp, kr0 = rs + 2 * rp, c16 = 16 * ch + 16 * cc;
#pragma unroll
        for (int i = 0; i < 16; ++i) {
            const int kj = crow(i, hi), krow = kr0 + (kj >> 4), kc = c16 + (kj & 15);
            int ci = kc - qc + 15; ci = ci < 0 ? 0 : (ci > 30 ? 30 : ci);
            const float bv = bh[(krow - r + 7) * 31 + ci];
            S[i] = (kc >= cst && kc < cst + 16) ? S[i] + bv : -__builtin_inff();
        }
    }
    float bm = S[0];
#pragma unroll
    for (int i = 1; i < 16; ++i) bm = fmaxf(bm, S[i]);
    bm = fmaxf(bm, __shfl_xor(bm, 32));
    const float mn = fmaxf(st.mrun, bm), alpha = __builtin_amdgcn_exp2f(st.mrun - mn);
    st.mrun = mn;
    float ps = 0.f;
#pragma unroll
    for (int i = 0; i < 16; ++i) { S[i] = __builtin_amdgcn_exp2f(S[i] - mn); ps += S[i]; }
    st.lsum = st.lsum * alpha + ps;
#pragma unroll
    for (int i = 0; i < 16; ++i) { st.o0[i] *= alpha; st.o1[i] *= alpha; }
    u32x4 pw0, pw1;
    pw0.x = cvtpk2(S[0], S[1]); pw0.y = cvtpk2(S[2], S[3]); pw0.z = cvtpk2(S[4], S[5]); pw0.w = cvtpk2(S[6], S[7]);
    pw1.x = cvtpk2(S[8], S[9]); pw1.y = cvtpk2(S[10], S[11]); pw1.z = cvtpk2(S[12], S[13]); pw1.w = cvtpk2(S[14], S[15]);
    const bf16x8 pb0 = __builtin_bit_cast(bf16x8, pw0), pb1 = __builtin_bit_cast(bf16x8, pw1);
#define VFRAG(dh, s) __builtin_bit_cast(bf16x8, (u32x4){kv.v[dh][s][0].x, kv.v[dh][s][0].y, kv.v[dh][s][1].x, kv.v[dh][s][1].y})
    st.o0 = __builtin_amdgcn_mfma_f32_32x32x16_bf16(VFRAG(0, 0), pb0, st.o0, 0, 0, 0);
    st.o0 = __builtin_amdgcn_mfma_f32_32x32x16_bf16(VFRAG(0, 1), pb1, st.o0, 0, 0, 0);
    st.o1 = __builtin_amdgcn_mfma_f32_32x32x16_bf16(VFRAG(1, 0), pb0, st.o1, 0, 0, 0);
    st.o1 = __builtin_amdgcn_mfma_f32_32x32x16_bf16(VFRAG(1, 1), pb1, st.o1, 0, 0, 0);
#undef VFRAG
}
__device__ __forceinline__ void att_task(const bf16* Qb, const bf16* Kb, const bf16* Vt, bf16* Ob, const LAS float* bias, int h, int r, int ch, int lane) {
    const int q = lane & 31, hi = lane >> 5, qc = 32 * ch + q, tq = GRID_W * r + qc;
    int rs = r - 4; rs = rs < 0 ? 0 : (rs > 248 ? 248 : rs);
    int cst = qc - 8; cst = cst < 0 ? 0 : (cst > 48 ? 48 : cst);
    AttCtx c; c.Kq = (const GAS bf16*)(Kb + h * HD + 8 * hi); c.Vh = (const GAS bf16*)(Vt + (size_t)(h * HD + q) * MT + 4 * hi); c.rs = rs; c.ch = ch; c.q = q; c.hi = hi;
    AttKV ka, kb, kc;
    att_load(ka, c, 0); att_load(kb, c, 1);
    bf16x8 qf[4];
#pragma unroll
    for (int d0 = 0; d0 < 4; ++d0) qf[d0] = *(const GAS bf16x8*)(Qb + (size_t)tq * NAW + h * HD + d0 * 16 + 8 * hi);
    AttState st; st.mrun = -1e30f; st.lsum = 0.f;
#pragma unroll
    for (int i = 0; i < 16; ++i) { st.o0[i] = 0.f; st.o1[i] = 0.f; }
    const LAS float* bh = bias + h * 465;
    for (int b = 0; b < 18; b += 3) {
        att_load(kc, c, b + 2); att_compute(st, ka, qf, bh, b, r, rs, ch, qc, cst, hi);
        att_load(ka, c, b + 3); att_compute(st, kb, qf, bh, b + 1, r, rs, ch, qc, cst, hi);
        att_load(kb, c, b + 4); att_compute(st, kc, qf, bh, b + 2, r, rs, ch, qc, cst, hi);
    }
    att_compute(st, ka, qf, bh, 18, r, rs, ch, qc, cst, hi);
    att_compute(st, kb, qf, bh, 19, r, rs, ch, qc, cst, hi);
    float lsum = st.lsum + __shfl_xor(st.lsum, 32);
    const float inv = 1.0f / lsum;
    GAS bf16* orow = (GAS bf16*)(Ob + (size_t)tq * D + h * HD);
#pragma unroll
    for (int g4 = 0; g4 < 4; ++g4) {
        u32x2 w0, w1;
        w0.x = cvtpk2(st.o0[4 * g4] * inv, st.o0[4 * g4 + 1] * inv); w0.y = cvtpk2(st.o0[4 * g4 + 2] * inv, st.o0[4 * g4 + 3] * inv);
        w1.x = cvtpk2(st.o1[4 * g4] * inv, st.o1[4 * g4 + 1] * inv); w1.y = cvtpk2(st.o1[4 * g4 + 2] * inv, st.o1[4 * g4 + 3] * inv);
        *(GAS u32x2*)(orow + 8 * g4 + 4 * hi) = w0;
        *(GAS u32x2*)(orow + 32 + 8 * g4 + 4 * hi) = w1;
    }
}
__device__ __forceinline__ void pool_task(const bf16* Ub, bf16* Ob, int t0, int lane) {
    const int g = lane >> 4, hw = 1 << g;
    u32x4 rw[23];
#pragma unroll
    for (int j = 0; j < 23; ++j) { const int t = t0 - 8 + j; rw[j] = (t >= 0 && t < LSEQ) ? *(const GAS u32x4*)(Ub + (size_t)t * NAW + 8 * lane) : (u32x4){0u, 0u, 0u, 0u}; }
#pragma unroll
    for (int i = 0; i < 8; ++i) {
        const int t = t0 + i, ci = i + 8;
        int lo = t - hw; lo = lo < 0 ? 0 : lo; int hi_ = t + hw; hi_ = hi_ > LSEQ ? LSEQ : hi_;
        const float rc = 1.0f / (float)(hi_ - lo);
        u32x4 ow;
#pragma unroll
        for (int d = 0; d < 4; ++d) {
            float sl = 0.f, sh = 0.f, r1l, r1h, r2l, r2h, r4l, r4h;
#define ADDROW(j) do { sl += bf_lo(rw[j][d]); sh += bf_hi(rw[j][d]); } while (0)
            ADDROW(ci - 1); ADDROW(ci); r1l = sl; r1h = sh;
            ADDROW(ci - 2); ADDROW(ci + 1); r2l = sl; r2h = sh;
            ADDROW(ci - 4); ADDROW(ci - 3); ADDROW(ci + 2); ADDROW(ci + 3); r4l = sl; r4h = sh;
            ADDROW(ci - 8); ADDROW(ci - 7); ADDROW(ci - 6); ADDROW(ci - 5); ADDROW(ci + 4); ADDROW(ci + 5); ADDROW(ci + 6); ADDROW(ci + 7);
#undef ADDROW
            const float vl = g == 0 ? r1l : (g == 1 ? r2l : (g == 2 ? r4l : sl)), vh = g == 0 ? r1h : (g == 1 ? r2h : (g == 2 ? r4h : sh));
            ow[d] = cvtpk2(vl * rc - bf_lo(rw[ci][d]), vh * rc - bf_hi(rw[ci][d]));
        }
        *(GAS u32x4*)(Ob + (size_t)t * D + NAW + 8 * lane) = ow;
    }
}
__device__ __forceinline__ void att_phase(Frame& F) {
    LAS float* bias = (LAS float*)(F.lds + RING_OFF);
    for (int i = F.tid; i < NHEADS * 465; i += NWAVES * 64) bias[i] = F.in[11][i] * LOG2E;
    __syncthreads();
    const int gw = F.vcu * NWAVES + F.wave, NGW = F.G * NWAVES;
    const bf16* Qb = (const bf16*)(F.ws + WS_Q); const bf16* Kb = (const bf16*)(F.ws + WS_K); const bf16* Vt = (const bf16*)(F.ws + WS_VT); const bf16* Ub = (const bf16*)(F.ws + WS_U);
    bf16* Ob = (bf16*)(F.ws + WS_ACT);
    for (int T = gw; T < 4096; T += NGW) {
        const int blk = T >> 3, w8 = T & 7, x = (blk & 255) >> 5, bl = (blk & 31) + 32 * (blk >> 8);
        const int h = bl >> 3, rg = bl & 7, r = 32 * x + 4 * rg + (w8 >> 1), ch = w8 & 1;
        att_task(Qb, Kb, Vt, Ob, bias, h, r, ch, F.lane);
    }
    for (int T = gw; T < LSEQ / 8; T += NGW) pool_task(Ub, Ob, 8 * T, F.lane);
    __syncthreads();
}
__device__ __forceinline__ void conv_phase(Frame& F) {
    const int gw = F.vcu * NWAVES + F.wave, NGW = F.G * NWAVES, lane = F.lane;
    const bf16* BG = (const bf16*)(F.ws + WS_BG); const bf16* Z = (const bf16*)(F.ws + WS_Z); bf16* P = (bf16*)(F.ws + WS_ACT);
    const float* cw = F.in[15];
    for (int T = gw; T < LSEQ / 8; T += NGW) {
        const int t0 = 8 * T;
#pragma unroll
        for (int hf = 0; hf < 2; ++hf) {
            const int c0 = 512 * hf + 8 * lane;
            float w[3][8];
#pragma unroll
            for (int k = 0; k < 3; ++k) { const f32x4 a = *(const f32x4*)(cw + k * D + c0), b = *(const f32x4*)(cw + k * D + c0 + 4);
                w[k][0] = a.x; w[k][1] = a.y; w[k][2] = a.z; w[k][3] = a.w; w[k][4] = b.x; w[k][5] = b.y; w[k][6] = b.z; w[k][7] = b.w; }
            u32x4 zr[10];
#pragma unroll
            for (int j = 0; j < 10; ++j) { const int t = t0 - 1 + j; zr[j] = (t >= 0 && t < LSEQ) ? *(const GAS u32x4*)(Z + (size_t)t * D + c0) : (u32x4){0u, 0u, 0u, 0u}; }
#pragma unroll
            for (int i = 0; i < 8; ++i) {
                const u32x4 bg = *(const GAS u32x4*)(BG + (size_t)(t0 + i) * D + c0);
                u32x4 ow;
#pragma unroll
                for (int d = 0; d < 4; ++d) {
                    const float yl = w[0][2 * d] * bf_lo(zr[i][d]) + w[1][2 * d] * bf_lo(zr[i + 1][d]) + w[2][2 * d] * bf_lo(zr[i + 2][d]);
                    const float yh = w[0][2 * d + 1] * bf_hi(zr[i][d]) + w[1][2 * d + 1] * bf_hi(zr[i + 1][d]) + w[2][2 * d + 1] * bf_hi(zr[i + 2][d]);
                    ow[d] = cvtpk2(bf_lo(bg[d]) * yl, bf_hi(bg[d]) * yh);
                }
                *(GAS u32x4*)(P + (size_t)(t0 + i) * D + c0) = ow;
            }
        }
    }
}

__device__ __forceinline__ void mini_reduce(LAS float* red, const f32x16& acc, int wave, int lane, float (&out)[2]) {
#pragma unroll
    for (int i = 0; i < 16; ++i) red[(wave * 16 + i) * 64 + lane] = acc[i];
    __syncthreads();
#pragma unroll
    for (int j = 0; j < 2; ++j) { float sm = 0.f;
#pragma unroll
        for (int w = 0; w < 8; ++w) sm += red[(w * 16 + 2 * wave + j) * 64 + lane];
        out[j] = sm; }
}
__device__ __forceinline__ void ctx_down_mini(Frame& F, const float* gate_c) {
    const int lane = F.lane, wave = F.wave, hi = lane >> 5, r32 = lane & 31;
    LAS float* red = (LAS float*)(F.lds + RING_OFF);
    const bf16* Hc = (const bf16*)(F.ws + WS_H) + (size_t)LSEQ * DFF;
    const bf16* Wt = (const bf16*)(F.ws + WS_W2T);
    float* xres = (float*)(F.ws + WS_XRES);
    for (int T = F.vcu; T < 256; T += F.G) {
        const int rt = T >> 5, ct = T & 31, k0 = wave * 352 + 8 * hi;
        const GAS bf16* A = (const GAS bf16*)(Hc + (size_t)(32 * rt + r32) * DFF + k0);
        const GAS bf16* B = (const GAS bf16*)(Wt + (size_t)(32 * ct + r32) * DFF + k0);
        f32x16 acc;
#pragma unroll
        for (int i = 0; i < 16; ++i) acc[i] = 0.f;
#pragma unroll
        for (int hf = 0; hf < 2; ++hf) {
            bf16x8 af[11], bfr[11];
#pragma unroll
            for (int s = 0; s < 11; ++s) { af[s] = *(const GAS bf16x8*)(A + (hf * 11 + s) * 16); bfr[s] = *(const GAS bf16x8*)(B + (hf * 11 + s) * 16); }
#pragma unroll
            for (int s = 0; s < 11; ++s) acc = __builtin_amdgcn_mfma_f32_32x32x16_bf16(af[s], bfr[s], acc, 0, 0, 0);
        }
        float o[2]; mini_reduce(red, acc, wave, lane, o);
#pragma unroll
        for (int j = 0; j < 2; ++j) { const int row = 32 * rt + crow(2 * wave + j, hi), col = 32 * ct + r32;
            xres[(size_t)(LSEQ + row) * D + col] = F.in[2][(size_t)row * D + col] + 0.5f * gate_c[col] * o[j]; }
        __syncthreads();
    }
}
constexpr int HN_LD = D + 8;
__device__ __forceinline__ void ctx_kv_mini(Frame& F, const float* g, const float* shift, const float* scale) {
    const int lane = F.lane, wave = F.wave, hi = lane >> 5, r32 = lane & 31;
    LAS bf16* hn = (LAS bf16*)(F.lds + RING_OFF);
    LAS float* red = (LAS float*)(F.lds + RING_OFF + 32 * HN_LD * 2);
    const float* cres = (const float*)(F.ws + WS_XRES) + (size_t)LSEQ * D;
    const bf16* Wt = (const bf16*)(F.ws + WS_WINT) + (size_t)512 * D;
    bf16* Kb = (bf16*)(F.ws + WS_K); bf16* Vt = (bf16*)(F.ws + WS_VT);
    f32x4 Av[4], Bv[4];
#pragma unroll
    for (int j = 0; j < 4; ++j) { const int c = 4 * lane + 256 * j; const f32x4 gv = *(const f32x4*)(g + c), sc = *(const f32x4*)(scale + c); Av[j] = gv * (sc + 1.0f); Bv[j] = *(const f32x4*)(shift + c); }
    for (int T = F.vcu; T < 256; T += F.G) {
        const int rt = T >> 5, ct = T & 31;
#pragma unroll
        for (int rr = 0; rr < 4; ++rr) {
            const int lr = 4 * wave + rr;
            const GAS f32x4* xr = (const GAS f32x4*)(cres + (size_t)(32 * rt + lr) * D) + lane;
            f32x4 v[4]; float s2 = 0.f;
#pragma unroll
            for (int j = 0; j < 4; ++j) { v[j] = xr[64 * j]; s2 += (v[j].x * v[j].x + v[j].y * v[j].y) + (v[j].z * v[j].z + v[j].w * v[j].w); }
            const float rstd = 1.0f / sqrtf(wave_sum(s2) * (1.0f / D) + RMS_EPS);
#pragma unroll
            for (int j = 0; j < 4; ++j) { const f32x4 y = v[j] * rstd * Av[j] + Bv[j];
                *(LAS u32x2*)(hn + lr * HN_LD + 4 * lane + 256 * j) = (u32x2){pk2(y.x, y.y), pk2(y.z, y.w)}; }
        }
        __syncthreads();
        const int k0 = wave * 128 + 8 * hi;
        const GAS bf16* B = (const GAS bf16*)(Wt + (size_t)(32 * ct + r32) * D + k0);
        bf16x8 af[8], bfr[8];
#pragma unroll
        for (int s = 0; s < 8; ++s) { bfr[s] = *(const GAS bf16x8*)(B + s * 16); af[s] = *(const LAS bf16x8*)(hn + r32 * HN_LD + k0 + s * 16); }
        f32x16 acc;
#pragma unroll
        for (int i = 0; i < 16; ++i) acc[i] = 0.f;
#pragma unroll
        for (int s = 0; s < 8; ++s) acc = __builtin_amdgcn_mfma_f32_32x32x16_bf16(af[s], bfr[s], acc, 0, 0, 0);
        float o[2]; mini_reduce(red, acc, wave, lane, o);
#pragma unroll
        for (int j = 0; j < 2; ++j) { const int row = LSEQ + 32 * rt + crow(2 * wave + j, hi), col = 32 * ct + r32; const bf16 val = (bf16)f2bf(o[j]);
            if (ct < 16) Kb[(size_t)row * NAW + col] = val; else Vt[(size_t)(col - NAW) * MT + row] = val; }
        __syncthreads();
    }
}

struct Args { const float* in[18]; float* out; unsigned char* ws; int ph_lo, ph_hi; };
static_assert(sizeof(Args) == 18 * 8 + 8 + 8 + 8, "Args has no padding");

__device__ __forceinline__ void ffn_up(Frame& F, int widx, int M) {
    pg8::Gemm g{(const bf16*)(F.ws + WS_ACT), (const bf16*)(F.ws + WS_W13T + (size_t)widx * W13T_BYTES), M, 2 * DFF, D};
    pg8::StaticOrder S; S.init(M, 2 * DFF, F.G, (int)blockIdx.x);
    pg8::EpiSwiGLU E{(bf16*)(F.ws + WS_H), DFF};
    pg8::gemm_phase<pg8::EpiSwiGLU, pg8::StaticOrder, true, true>(F.lds + RING_OFF, g, S, E);
}
__device__ __forceinline__ void ffn_down(Frame& F, int widx, int M, const float* base_l, const float* base_c, const float* gate_l, const float* gate_c, float* outp) {
    pg8::Gemm g{(const bf16*)(F.ws + WS_H), (const bf16*)(F.ws + WS_W2T + (size_t)widx * W2T_BYTES), M, D, DFF};
    pg8::StaticOrder S; S.init(M, D, F.G, (int)blockIdx.x);
    pg8::EpiResid E{base_l, base_c, outp, gate_l, gate_c, 0.5f, LSEQ, D};
    pg8::gemm_phase<pg8::EpiResid, pg8::StaticOrder, true, true>(F.lds + RING_OFF, g, S, E);
}
__device__ __forceinline__ void proj_out(Frame& F, size_t wt_off, const float* gate, float* outp) {
    float* xres = (float*)(F.ws + WS_XRES);
    pg8::Gemm g{(const bf16*)(F.ws + WS_ACT), (const bf16*)(F.ws + wt_off), LSEQ, D, D};
    pg8::StaticOrder S; S.init(LSEQ, D, F.G, (int)blockIdx.x);
    pg8::EpiResid E{xres, xres, outp, gate, gate, 1.0f, LSEQ, D};
    pg8::gemm_phase<pg8::EpiResid, pg8::StaticOrder, true, true>(F.lds + RING_OFF, g, S, E);
}

__global__ void __launch_bounds__(NWAVES * 64, 2) mk_fwd(Args args) {
    extern __shared__ __attribute__((aligned(16))) unsigned char lds[];
    Frame F;
    F.lds = (LAS unsigned char*)lds;
    F.MISC = (volatile LAS unsigned*)(F.lds + MISC_OFF);
    F.tid = threadIdx.x; F.lane = F.tid & 63; F.wave = __builtin_amdgcn_readfirstlane(F.tid >> 6);
    F.G = gridDim.x; { const int bx = blockIdx.x; F.vcu = (F.G % 8 == 0) ? (bx % 8) * (F.G / 8) + bx / 8 : bx; }
    F.ws = args.ws; F.out = args.out; F.ctl = (gu32*)(args.ws + WS_CTL);
#pragma unroll
    for (int i = 0; i < 18; ++i) F.in[i] = args.in[i];
    for (int u = F.tid; u < (LDS_BYTES - LDSCTL_OFF) / 4; u += NWAVES * 64) ((LAS unsigned*)(F.lds + LDSCTL_OFF))[u] = 0u;
    __syncthreads();
    const int lo = args.ph_lo, hi = args.ph_hi;
    const bool multi = (hi - lo) > 1;
    XcdBarrier bar; bar.bar = (unsigned*)(F.ctl + CW_BAR); bar.x = 0; bar.st = nullptr;
    if (multi) bar = xcd_barrier_post((unsigned*)(F.ctl + CW_BAR), F.MISC + 8);
#define IN(k) (lo <= (k) && (k) < hi)
#define SEAM(k) do { if (IN(k) && IN((k) + 1)) xcd_barrier(bar); } while (0)
    const float* mv = (const float*)(F.ws + WS_MOD);
    const float* ml0 = mv; const float* mc0 = mv + MODW; const float* ml1 = mv + 2 * MODW;
    float* xres = (float*)(F.ws + WS_XRES);
    bf16* act = (bf16*)(F.ws + WS_ACT);
    const float* ng = F.in[6];

#ifndef PROBE_MASK
#define PROBE_MASK 0u
#endif
#define PH(k, ...) do { if (IN(k)) { if ((PROBE_MASK >> (k)) & 1u) { const bool dup = true; (void)dup; __VA_ARGS__ xcd_barrier(bar); } { const bool dup = false; (void)dup; __VA_ARGS__ } } SEAM(k); } while (0)
    PH(0, { p0_prologue(F); });
    PH(1, { norm_rows_bf16(F, F.in[0], act, LSEQ, ng + 0 * D, ml0 + 0 * D, ml0 + 1 * D);
            norm_rows_bf16(F, F.in[2], act + (size_t)LSEQ * D, NCTX, ng + 0 * D, mc0 + 0 * D, mc0 + 1 * D); });
    PH(2, { ffn_up(F, 0, MT); });
    PH(3, { ctx_down_mini(F, mc0 + 2 * D); ffn_down(F, 0, LSEQ, F.in[0], F.in[0], ml0 + 2 * D, ml0 + 2 * D, xres); });
    PH(4, { norm_rows_bf16(F, xres, act, LSEQ, ng + 1 * D, ml0 + 3 * D, ml0 + 4 * D); });
    PH(5, {
        ctx_kv_mini(F, ng + 1 * D, mc0 + 3 * D, mc0 + 4 * D);
        pg8::Gemm g{(const bf16*)act, (const bf16*)(F.ws + WS_WINT), LSEQ, 2048, D};
        pg8::StaticOrder S; S.init(LSEQ, 2048, F.G, (int)blockIdx.x);
        pg8::EpiWin E{F.ws + WS_Q, (bf16*)(F.ws + WS_VT), 0.125f * LOG2E, MT, (unsigned)(WS_K - WS_Q), (unsigned)(WS_U - WS_Q)};
        pg8::gemm_phase<pg8::EpiWin, pg8::StaticOrder, true, true>(F.lds + RING_OFF, g, S, E);
    });
    PH(6, { att_phase(F); });
    PH(7, { proj_out(F, WS_WOUTT, ml0 + 5 * D, dup ? F.out : xres); });
    PH(8, { norm_rows_bf16(F, xres, act, LSEQ, ng + 2 * D, ml0 + 6 * D, ml0 + 7 * D); });
    PH(9, { ffn_up(F, 1, LSEQ); });
    PH(10, { ffn_down(F, 1, LSEQ, xres, xres, ml0 + 8 * D, ml0 + 8 * D, dup ? F.out : xres); });
    PH(11, { norm_rows_bf16(F, xres, act, LSEQ, ng + 3 * D, ml1 + 0 * D, ml1 + 1 * D); });
    PH(12, { ffn_up(F, 2, LSEQ); });
    PH(13, { ffn_down(F, 2, LSEQ, xres, xres, ml1 + 2 * D, ml1 + 2 * D, dup ? F.out : xres); });
    PH(14, { norm_rows_bf16(F, xres, act, LSEQ, ng + 4 * D, ml1 + 3 * D, ml1 + 4 * D); });
    PH(15, {
        pg8::Gemm g{(const bf16*)act, (const bf16*)(F.ws + WS_CINT), LSEQ, 3 * D, D};
        pg8::StaticOrder S; S.init(LSEQ, 3 * D, F.G, (int)blockIdx.x);
        pg8::EpiCin E{(bf16*)(F.ws + WS_BG), (bf16*)(F.ws + WS_Z)};
        pg8::gemm_phase<pg8::EpiCin, pg8::StaticOrder, true, true>(F.lds + RING_OFF, g, S, E);
    });
    PH(16, { conv_phase(F); });
    PH(17, { proj_out(F, WS_COUTT, ml1 + 5 * D, dup ? F.out : xres); });
    PH(18, { norm_rows_bf16(F, xres, act, LSEQ, ng + 5 * D, ml1 + 6 * D, ml1 + 7 * D); });
    PH(19, { ffn_up(F, 3, LSEQ); });
    PH(20, { ffn_down(F, 3, LSEQ, xres, xres, ml1 + 8 * D, ml1 + 8 * D, dup ? F.out : xres); });
    PH(21, { norm_rows_final(F, xres, F.out, LSEQ, F.in[17]); });
#undef PH
#undef IN
#undef SEAM
}

#ifndef MK_PER_PHASE
#define MK_PER_PHASE 0
#endif
extern "C" void kernel_launch(void* const* d_in, const int* in_sizes, int n_in, void* d_out, int out_size, void* d_ws, size_t ws_size, hipStream_t stream) {
    static int grid = 0;
    if (grid == 0) {
        if (n_in != 18 || in_sizes[0] != LSEQ * D || out_size != LSEQ * D || ws_size < WS_END) { fprintf(stderr, "kernel_launch: shape/workspace mismatch (n_in %d, in0 %d, out %d, ws %zu)\n", n_in, n_in > 0 ? in_sizes[0] : -1, out_size, ws_size); grid = -1; return; }
        int dev = 0, cus = 0;
        if (hipGetDevice(&dev) != hipSuccess || hipDeviceGetAttribute(&cus, hipDeviceAttributeMultiprocessorCount, dev) != hipSuccess) { grid = -1; return; }
        if (hipFuncSetAttribute((const void*)mk_fwd, hipFuncAttributeMaxDynamicSharedMemorySize, LDS_BYTES) != hipSuccess) { fprintf(stderr, "kernel_launch: hipFuncSetAttribute failed\n"); grid = -1; return; }
        (void)hipGetLastError();
        grid = cus;
    }
    if (grid < 0) return;
    if (hipMemsetAsync((char*)d_ws + WS_CTL, 0, CTL_ZERO_BYTES, stream) != hipSuccess) return;
    Args a{};
    for (int i = 0; i < 18; ++i) a.in[i] = (const float*)d_in[i];
    a.out = (float*)d_out; a.ws = (unsigned char*)d_ws;
#if MK_PER_PHASE
    for (int p = 0; p < N_PHASES; ++p) { a.ph_lo = p; a.ph_hi = p + 1; hipLaunchKernelGGL(mk_fwd, dim3(grid), dim3(NWAVES * 64), LDS_BYTES, stream, a); }
#else
    a.ph_lo = 0; a.ph_hi = N_PHASES; hipLaunchKernelGGL(mk_fwd, dim3(grid), dim3(NWAVES * 64), LDS_BYTES, stream, a);
#endif
}
```
